# Optimizing an MI355X kernel written in HIP

```python
import jax, jax.numpy as jnp
from jax import lax
import numpy as np

D_MODEL = 2048
BATCH = 8
SEQ = 2048
DEPTH = 1

D_MIX = D_MODEL
NSA_WIDTH = D_MIX // 2
NSA_HEAD_DIM = 64
NSA_HEADS = NSA_WIDTH // NSA_HEAD_DIM
NSA_KV_HEADS = 4
NSA_GROUP = NSA_HEADS // NSA_KV_HEADS
NSA_KV_WIDTH = NSA_KV_HEADS * NSA_HEAD_DIM
CMP_BLOCK = 32
CMP_STRIDE = 16
CMP_HIDDEN = 4 * NSA_HEAD_DIM
SEL_BLOCK = 64
SEL_TOP = 8
SEL_BONUS = 1.0e4
WINDOW = 512
Q_BLOCK = 128
HGRN_WIDTH = D_MIX - NSA_WIDTH
HGRN_HEAD_DIM = 128
HGRN_HEADS = HGRN_WIDTH // HGRN_HEAD_DIM
HGRN_CHUNK = 64
EPS = 1e-6
NEG_INF = -1e30
IN_SPLITS = [NSA_WIDTH] + [NSA_KV_WIDTH] * 6 + [3 * NSA_HEADS, NSA_WIDTH] + [HGRN_WIDTH] * 4
D_IN = sum(IN_SPLITS)

kernel_name = "hymba_nsa_hgrn2_layer"


def rmsnorm(x, g):
    xf = x.astype(jnp.float32)
    y = xf * lax.rsqrt(jnp.mean(xf * xf, axis=-1, keepdims=True) + EPS)
    return (y * g.astype(jnp.float32)).astype(x.dtype)


def head_rmsnorm(x, g, n_heads):
    B, S, W = x.shape
    xh = x.astype(jnp.float32).reshape(B, S, n_heads, W // n_heads)
    y = xh * lax.rsqrt(jnp.mean(xh * xh, axis=-1, keepdims=True) + EPS)
    return (y.reshape(B, S, W) * g.astype(jnp.float32)).astype(x.dtype)


def alibi_slopes(n):
    return jnp.asarray(2.0 ** (-8.0 * np.arange(1, n + 1) / n), dtype=jnp.float32)


def masked_softmax(logits, mask):
    logits = jnp.where(mask, logits, NEG_INF)
    return jax.nn.softmax(logits, axis=-1) * mask


def compress_blocks(kv, pe, w1, w2):
    B, S, G, dh = kv.shape
    n_cmp = (S - CMP_BLOCK) // CMP_STRIDE + 1
    idx = CMP_STRIDE * np.arange(n_cmp)[:, None] + np.arange(CMP_BLOCK)[None, :]
    blk = kv[:, idx] + pe[:, None, :]
    blk = blk.transpose(0, 1, 3, 2, 4).reshape(B, n_cmp, G, CMP_BLOCK * dh)
    return jax.nn.gelu(blk @ w1) @ w2


def nsa_mixer(q, k_cmp, v_cmp, k_slc, v_slc, k_win, v_win, gate,
              pe_k, w1_k, w2_k, pe_v, w1_v, w2_v):
    B, S = q.shape[:2]
    G, R, dh = NSA_KV_HEADS, NSA_GROUP, NSA_HEAD_DIM
    q = q.reshape(B, S, G, R, dh) * (dh ** -0.5)
    kv4 = lambda a: a.reshape(B, S, G, dh)
    k_cmp, v_cmp, k_slc, v_slc, k_win, v_win = map(kv4, (k_cmp, v_cmp, k_slc, v_slc, k_win, v_win))
    slopes = alibi_slopes(NSA_HEADS).reshape(G, R)[:, :, None, None]
    t = jnp.arange(S)

    kc = compress_blocks(k_cmp, pe_k, w1_k, w2_k)
    vc = compress_blocks(v_cmp, pe_v, w1_v, w2_v)
    n_cmp = kc.shape[1]
    c_end = CMP_STRIDE * jnp.arange(n_cmp) + CMP_BLOCK - 1
    dist_c = t[:, None] - c_end[None, :]
    logits = jnp.einsum('btgrd,bngd->bgrtn', q, kc).astype(jnp.float32) - slopes * dist_c
    p_cmp = masked_softmax(logits, dist_c >= 0)
    o_cmp = jnp.einsum('bgrtn,bngd->btgrd', p_cmp.astype(vc.dtype), vc)

    n_sel = S // SEL_BLOCK
    top = min(SEL_TOP, n_sel)
    cs = CMP_STRIDE * np.arange(n_cmp)[:, None]
    ss = SEL_BLOCK * np.arange(n_sel)[None, :]
    overlap = np.clip(np.minimum(cs + CMP_BLOCK, ss + SEL_BLOCK) - np.maximum(cs, ss), 0, None)
    m_map = jnp.asarray(overlap / CMP_BLOCK, dtype=jnp.float32)
    p_slc = jnp.einsum('bgtn,nj->bgtj', p_cmp.sum(axis=2), m_map)
    j = jnp.arange(n_sel)[None, :]
    cur = (t // SEL_BLOCK)[:, None]
    forced = ((j == 0) | (j == cur) | (j == cur - 1)).astype(jnp.float32)
    future = j * SEL_BLOCK > t[:, None]
    score = jnp.where(future, -1.0, p_slc + SEL_BONUS * forced)
    _, sel_idx = lax.top_k(score, top)

    k_blocks = k_slc.reshape(B, n_sel, SEL_BLOCK, G, dh).transpose(0, 3, 1, 2, 4)
    v_blocks = v_slc.reshape(B, n_sel, SEL_BLOCK, G, dh).transpose(0, 3, 1, 2, 4)
    nq = S // Q_BLOCK
    q_chunks = q.reshape(B, nq, Q_BLOCK, G, R, dh).transpose(1, 0, 3, 4, 2, 5)
    idx_chunks = sel_idx.reshape(B, G, nq, Q_BLOCK, top).transpose(2, 0, 1, 3, 4)
    gather = jax.vmap(jax.vmap(lambda blocks, ids: blocks[ids]))
    n_tok = top * SEL_BLOCK

    def sel_block(args):
        qc, ic, c = args
        kg = gather(k_blocks, ic).reshape(B, G, Q_BLOCK, n_tok, dh)
        vg = gather(v_blocks, ic).reshape(B, G, Q_BLOCK, n_tok, dh)
        pos = (ic[..., None] * SEL_BLOCK + jnp.arange(SEL_BLOCK)).reshape(B, G, Q_BLOCK, n_tok)
        t_c = c * Q_BLOCK + jnp.arange(Q_BLOCK)
        dist = (t_c[:, None] - pos)[:, :, None]
        lg = jnp.einsum('bgrqd,bgqkd->bgrqk', qc, kg).astype(jnp.float32) - slopes * dist
        p = masked_softmax(lg, dist >= 0)
        return jnp.einsum('bgrqk,bgqkd->bgrqd', p.astype(vg.dtype), vg)

    o_slc = lax.map(sel_block, (q_chunks, idx_chunks, jnp.arange(nq)))
    o_slc = o_slc.transpose(1, 0, 4, 2, 3, 5).reshape(B, S, G, R, dh)

    span = WINDOW + Q_BLOCK
    k_pad = jnp.pad(k_win, ((0, 0), (WINDOW, 0), (0, 0), (0, 0)))
    v_pad = jnp.pad(v_win, ((0, 0), (WINDOW, 0), (0, 0), (0, 0)))

    def win_block(args):
        qc, c = args
        start = c * Q_BLOCK
        kw = lax.dynamic_slice_in_dim(k_pad, start, span, axis=1)
        vw = lax.dynamic_slice_in_dim(v_pad, start, span, axis=1)
        pos = start - WINDOW + jnp.arange(span)
        t_c = start + jnp.arange(Q_BLOCK)
        dist = t_c[:, None] - pos[None, :]
        mask = (pos[None, :] >= 0) & (dist >= 0) & (dist < WINDOW)
        lg = jnp.einsum('bgrqd,bkgd->bgrqk', qc, kw).astype(jnp.float32) - slopes * dist
        p = masked_softmax(lg, mask)
        return jnp.einsum('bgrqk,bkgd->bgrqd', p.astype(vw.dtype), vw)

    o_win = lax.map(win_block, (q_chunks, jnp.arange(nq)))
    o_win = o_win.transpose(1, 0, 4, 2, 3, 5).reshape(B, S, G, R, dh)

    g = jax.nn.sigmoid(gate.reshape(B, S, G, R, 3))
    o = g[..., 0:1] * o_cmp + g[..., 1:2] * o_slc + g[..., 2:3] * o_win
    return o.reshape(B, S, NSA_WIDTH)


def hgrn2_mixer(q, f_pre, v, lb):
    out_dtype = q.dtype
    B, S, W = q.shape
    H, dh, C = HGRN_HEADS, HGRN_HEAD_DIM, HGRN_CHUNK
    nc = S // C
    qf, vf = q.astype(jnp.float32), v.astype(jnp.float32)
    f = lb + (1.0 - lb) * jax.nn.sigmoid(f_pre.astype(jnp.float32))
    k = 1.0 - f
    log_f = jnp.log(f)
    chunk = lambda a: a.reshape(B, nc, C, H, dh).transpose(1, 0, 3, 2, 4)
    causal = jnp.tril(jnp.ones((C, C), dtype=bool))[:, :, None]

    def step(state, xs):
        qc, kc, vc, lfc = xs
        b = jnp.cumsum(lfc, axis=2)
        o_inter = jnp.einsum('bhtd,bhde->bhte', qc * jnp.exp(b), state)
        decay = jnp.exp(jnp.where(causal, b[:, :, :, None, :] - b[:, :, None, :, :], -jnp.inf))
        attn = jnp.einsum('bhtd,bhsd,bhtsd->bhts', qc, kc, decay)
        o = o_inter + jnp.einsum('bhts,bhse->bhte', attn, vc)
        b_last = b[:, :, -1:, :]
        state = jnp.exp(b_last[:, :, 0, :])[..., None] * state + \
            jnp.einsum('bhsd,bhse->bhde', kc * jnp.exp(b_last - b), vc)
        return state, o

    state0 = jnp.zeros((B, H, dh, dh), dtype=jnp.float32)
    _, o = lax.scan(step, state0, (chunk(qf), chunk(k), chunk(vf), chunk(log_f)))
    return o.transpose(1, 0, 3, 2, 4).reshape(B, S, W).astype(out_dtype)


def setup_inputs(seed: int = 0) -> dict:
    key = jax.random.key(seed)
    ks = jax.random.split(key, 16)
    nrm = lambda k, shape, s: jax.random.normal(k, shape, dtype=jnp.float32) * s
    gain = lambda k, shape: 1.0 + nrm(k, shape, 0.02)
    return {
        "x": nrm(ks[0], (BATCH, SEQ, D_MODEL), 1.0),
        "norm_in": gain(ks[1], (DEPTH, D_MODEL)),
        "w_in": nrm(ks[2], (DEPTH, D_MODEL, D_IN), D_MODEL ** -0.5),
        "cmp_pe_k": nrm(ks[3], (DEPTH, CMP_BLOCK, NSA_HEAD_DIM), 0.1),
        "cmp_w1_k": nrm(ks[4], (DEPTH, CMP_BLOCK * NSA_HEAD_DIM, CMP_HIDDEN), (CMP_BLOCK * NSA_HEAD_DIM) ** -0.5),
        "cmp_w2_k": nrm(ks[5], (DEPTH, CMP_HIDDEN, NSA_HEAD_DIM), CMP_HIDDEN ** -0.5),
        "cmp_pe_v": nrm(ks[6], (DEPTH, CMP_BLOCK, NSA_HEAD_DIM), 0.1),
        "cmp_w1_v": nrm(ks[7], (DEPTH, CMP_BLOCK * NSA_HEAD_DIM, CMP_HIDDEN), (CMP_BLOCK * NSA_HEAD_DIM) ** -0.5),
        "cmp_w2_v": nrm(ks[8], (DEPTH, CMP_HIDDEN, NSA_HEAD_DIM), CMP_HIDDEN ** -0.5),
        "lower_bounds": nrm(ks[9], (DEPTH + 1, HGRN_WIDTH), 0.1),
        "nsa_out_norm": gain(ks[10], (DEPTH, NSA_WIDTH)),
        "hgrn_out_norm": gain(ks[11], (DEPTH, HGRN_WIDTH)),
        "w_out": nrm(ks[12], (DEPTH, D_MIX, D_MODEL), D_MIX ** -0.5),
        "final_norm": gain(ks[13], (D_MODEL,)),
    }


def reference(x, norm_in, w_in, cmp_pe_k, cmp_w1_k, cmp_w2_k, cmp_pe_v, cmp_w1_v, cmp_w2_v,
              lower_bounds, nsa_out_norm, hgrn_out_norm, w_out, final_norm):
    split_at = np.cumsum(IN_SPLITS)[:-1].tolist()
    lbs = jnp.cumsum(jax.nn.softmax(lower_bounds.astype(jnp.float32), axis=0), axis=0)
    for l in range(DEPTH):
        h = rmsnorm(x, norm_in[l])
        proj = h @ w_in[l]
        (q_a, k_cmp, v_cmp, k_slc, v_slc, k_win, v_win, gate_a, z_a,
         q_h, f_h, i_h, z_h) = jnp.split(proj, split_at, axis=-1)
        o_a = nsa_mixer(q_a, k_cmp, v_cmp, k_slc, v_slc, k_win, v_win, gate_a,
                        cmp_pe_k[l], cmp_w1_k[l], cmp_w2_k[l], cmp_pe_v[l], cmp_w1_v[l], cmp_w2_v[l])
        o_h = hgrn2_mixer(q_h, f_h, i_h, lbs[l])
        o_a = head_rmsnorm(o_a, nsa_out_norm[l], NSA_HEADS) * jax.nn.silu(z_a)
        o_h = head_rmsnorm(o_h, hgrn_out_norm[l], HGRN_HEADS) * jax.nn.silu(z_h)
        mixed = jnp.concatenate([o_a, o_h], axis=-1)
        x = x + mixed @ w_out[l]
    return rmsnorm(x, final_norm)
```

```cpp
#include <hip/hip_runtime.h>
#include <hip/hip_cooperative_groups.h>
#include <cstdio>
#include <cstdint>
namespace cg = cooperative_groups;

#ifndef MK_LAUNCHES
#define MK_LAUNCHES 1
#endif
namespace pg8 {
#define PG8_LAS __attribute__((address_space(3)))
typedef unsigned short bf16_t;
typedef short bf16x8 __attribute__((ext_vector_type(8)));
typedef float f32x4 __attribute__((ext_vector_type(4)));
typedef unsigned u32x4 __attribute__((ext_vector_type(4)));
constexpr int BM = 256, BK = 64, HALF = 128, HTB = HALF * BK * 2  , STAGE_BYTES = 8 * HTB, NXCD = 8, WGM = 8;

__host__ __device__ __forceinline__ int lds_byte(int r, int c) { const int st = (r >> 4) * 2 + (c >> 5), rr = r & 15, cc = c & 31, ob = rr * 64 + cc * 2; return st * 1024 + (ob ^ (((ob >> 9) & 1) << 5)); }
__host__ __device__ __forceinline__ void stage_rc(int b, int& R, int& C) { const int st = b / 1024, sb = b % 1024, swz = sb ^ (((sb >> 9) & 1) << 5); R = (st >> 1) * 16 + swz / 64; C = (st & 1) * 32 + (swz % 64) / 2; }
__host__ __device__ __forceinline__ int perm32(int rho) { const int n = rho >> 4, i = rho & 15; return 8 * (i >> 2) + 4 * n + (i & 3); }

struct Unit { int pm, pn; };
struct Gemm { const bf16_t* A; const bf16_t* Bt; int M, N, K; };

struct StaticOrder {
    int nM, nN, nwg, G, c;
    __host__ __device__ void init(int M, int N, int G_, int c_) { nM = M / BM; nN = N / BM; nwg = nM * nN; G = G_; c = c_; }
    __host__ __device__ bool next(int i, Unit& u) const {
        const long L = (long)i * G + c; if (L >= nwg) return false;
        int wgid = (int)L; { const int q = nwg / NXCD, r = nwg % NXCD, xcd = wgid % NXCD, off = wgid / NXCD; wgid = (xcd < r ? xcd * (q + 1) : r * (q + 1) + (xcd - r) * q) + off; }
        const int nig = WGM * nN, gid = wgid / nig, fm = gid * WGM, gsz = (nM - fm) < WGM ? (nM - fm) : WGM;
        u.pm = fm + ((wgid % nig) % gsz); u.pn = (wgid % nig) / gsz; return true;
    }
    __device__ __forceinline__ void a_ready(const Unit&) const {}
    __device__ __forceinline__ void done(const Unit&) const {}
};

typedef float f32x2 __attribute__((ext_vector_type(2)));
typedef __bf16 bf16x2_t __attribute__((ext_vector_type(2)));
__device__ __forceinline__ unsigned cvt_pk_bf16(float lo, float hi) { f32x2 v = {lo, hi}; bf16x2_t b = __builtin_convertvector(v, bf16x2_t); return __builtin_bit_cast(unsigned, b); }

struct EpiProj {
    static constexpr bool PERM = true, AFTER_DRAIN = false;
    bf16_t* O; int ldc; int nq; float qscale;
    __device__ __forceinline__ void operator()(const f32x4 (&acc)[2][2][4][2], const Unit& u, int wr, int wc, int fr, int fq) const {
        const int row0 = u.pm * BM + wr * 64 + fr; const int col0 = u.pn * BM + wc * 32 + 8 * fq;
        const float sc = (u.pn < nq) ? qscale : 1.f;
#pragma unroll
        for (int ai = 0; ai < 2; ++ai)
#pragma unroll
            for (int m = 0; m < 4; ++m) { bf16_t* rowp = O + (size_t)(row0 + ai * HALF + m * 16) * ldc + col0;
#pragma unroll
                for (int bj = 0; bj < 2; ++bj) { const f32x4 v0 = acc[ai][bj][m][0] * sc, v1 = acc[ai][bj][m][1] * sc;
                    u32x4 w; w.x = cvt_pk_bf16(v0[0], v0[1]); w.y = cvt_pk_bf16(v0[2], v0[3]); w.z = cvt_pk_bf16(v1[0], v1[1]); w.w = cvt_pk_bf16(v1[2], v1[3]);
                    *(u32x4*)(rowp + bj * HALF) = w; } }
    }
};
struct EpiRes {
    static constexpr bool PERM = false, AFTER_DRAIN = false;
    const float* base; float* out; int ldc; float* part; int M;
    __device__ __forceinline__ void operator()(const f32x4 (&acc)[2][2][4][2], const Unit& u, int wr, int wc, int fr, int fq) const {
        const int col0 = u.pn * BM + wc * 32 + 4 * fq;
#pragma unroll
        for (int ai = 0; ai < 2; ++ai)
#pragma unroll
            for (int m = 0; m < 4; ++m) { const int r = u.pm * BM + ai * HALF + wr * 64 + m * 16 + fr; const size_t off = (size_t)r * ldc + col0; float ss = 0.f;
#pragma unroll
                for (int bj = 0; bj < 2; ++bj)
#pragma unroll
                    for (int n = 0; n < 2; ++n) { const f32x4 bs = *(const f32x4*)(base + off + bj * HALF + n * 16); const f32x4 y = bs + acc[ai][bj][m][n];
                        *(f32x4*)(out + off + bj * HALF + n * 16) = y; ss += (y[0] * y[0] + y[1] * y[1]) + (y[2] * y[2] + y[3] * y[3]); }
                ss += __shfl_xor(ss, 16); ss += __shfl_xor(ss, 32);
                if (fq == 0) part[(size_t)(4 * u.pn + wc) * M + r] = ss; }
    }
};
template <class Epi, class Sched, bool ALIGN_EPI = false, bool SP2 = false>
__device__ __forceinline__ void gemm_phase(PG8_LAS unsigned char* lds, const Gemm g, const Sched& S, const Epi& E) {
    const int tid = threadIdx.x, wid = __builtin_amdgcn_readfirstlane(tid >> 6), lane = tid & 63, wr = wid >> 2, wc = wid & 3, fr = lane & 15, fq = lane >> 4;
    const int K = g.K, nt = K / BK;
    unsigned voffA[2], voffB[2];
#pragma unroll
    for (int i = 0; i < 2; ++i) { int R, C; stage_rc(tid * 16 + i * 8192, R, C); const int Rb = Epi::PERM ? ((R & ~31) + perm32(R & 31)) : R;
        voffA[i] = (unsigned)(R * K + C) * 2u; voffB[i] = (unsigned)(Rb * K + C) * 2u; }
    const size_t kstep = (size_t)(BK * 2);
    const size_t hstep = (size_t)HALF * K * 2;
    const size_t tstep = 2 * hstep;
    const unsigned ldsw = (unsigned)wid * 1024u;
    const int aoff = lds_byte(wr * 64 + fr, fq * 8), boff = lds_byte(wc * 32 + fr, fq * 8);
#define PG8_SA(b, h) (((b) * 2 + (h)) * HTB)
#define PG8_SB(b, h) ((4 + (b) * 2 + (h)) * HTB)
#define PG8_STAGE(bufoff, gbase, voff) do { _Pragma("unroll") for (int _i = 0; _i < 2; ++_i) \
        __builtin_amdgcn_global_load_lds((const unsigned*)((const char*)(gbase) + (voff)[_i]), (PG8_LAS unsigned*)(lds + (bufoff) + ldsw + _i * 8192), 16, 0, 0); } while (0)
#define PG8_LDA(dst, b, h) do { _Pragma("unroll") for (int m = 0; m < 4; ++m) _Pragma("unroll") for (int k = 0; k < 2; ++k) dst[m][k] = *(const PG8_LAS bf16x8*)(lds + PG8_SA(b, h) + aoff + m * 2048 + k * 1024); } while (0)
#define PG8_LDB(dst, b, h) do { _Pragma("unroll") for (int n = 0; n < 2; ++n) _Pragma("unroll") for (int k = 0; k < 2; ++k) dst[n][k] = *(const PG8_LAS bf16x8*)(lds + PG8_SB(b, h) + boff + n * 2048 + k * 1024); } while (0)
#define PG8_MMA(ai, bj, At, Bt) do { __builtin_amdgcn_s_setprio(1); _Pragma("unroll") for (int m = 0; m < 4; ++m) _Pragma("unroll") for (int n = 0; n < 2; ++n) _Pragma("unroll") for (int k = 0; k < 2; ++k) \
        acc[ai][bj][m][n] = __builtin_amdgcn_mfma_f32_16x16x32_bf16(Bt[n][k], At[m][k], acc[ai][bj][m][n], 0, 0, 0); __builtin_amdgcn_s_setprio(0); } while (0)
#define PG8_WAIT_V(n) asm volatile("s_waitcnt vmcnt(" #n ")" ::: "memory")
#define PG8_WAIT_L(n) asm volatile("s_waitcnt lgkmcnt(" #n ")" ::: "memory")
#define PG8_BAR __builtin_amdgcn_s_barrier()
#define PG8_SCHED __builtin_amdgcn_sched_barrier(0)
    Unit cur, nxt; int ui = 0;
    if (!S.next(0, cur)) return;
    f32x4 acc[2][2][4][2];
#pragma unroll
    for (int a = 0; a < 2; ++a)
#pragma unroll
        for (int b = 0; b < 2; ++b)
#pragma unroll
            for (int m = 0; m < 4; ++m)
#pragma unroll
                for (int n = 0; n < 2; ++n) acc[a][b][m][n] = (f32x4){0.f, 0.f, 0.f, 0.f};
    bf16x8 At[4][2], B0[2][2], B1[2][2];
    const char* cA = (const char*)g.A + (size_t)cur.pm * tstep; const char* cB = (const char*)g.Bt + (size_t)cur.pn * tstep;
    S.a_ready(cur);
    if constexpr (SP2) {
        PG8_STAGE(PG8_SB(0, 0), cB, voffB); PG8_STAGE(PG8_SB(0, 1), cB + hstep, voffB); PG8_STAGE(PG8_SA(0, 0), cA, voffA); PG8_STAGE(PG8_SA(0, 1), cA + hstep, voffA);
        if (wr == 1) PG8_BAR;
        PG8_WAIT_V(2); PG8_BAR;
        PG8_STAGE(PG8_SB(1, 0), cB + kstep, voffB); PG8_STAGE(PG8_SA(1, 0), cA + kstep, voffA); PG8_STAGE(PG8_SB(1, 1), cB + hstep + kstep, voffB);
        PG8_WAIT_V(6); PG8_BAR;
    } else {
        PG8_STAGE(PG8_SB(0, 0), cB, voffB); PG8_STAGE(PG8_SA(0, 0), cA, voffA); PG8_STAGE(PG8_SB(0, 1), cB + hstep, voffB); PG8_STAGE(PG8_SA(0, 1), cA + hstep, voffA);
        if (wr == 1) PG8_BAR;
        PG8_WAIT_V(4); PG8_BAR;
        PG8_STAGE(PG8_SB(1, 0), cB + kstep, voffB); PG8_STAGE(PG8_SA(1, 0), cA + kstep, voffA); PG8_STAGE(PG8_SB(1, 1), cB + hstep + kstep, voffB);
        PG8_WAIT_V(6); PG8_BAR;
    }
    for (;;) {
        const bool has_next = S.next(ui + 1, nxt);
        const char* nA = has_next ? (const char*)g.A + (size_t)nxt.pm * tstep : cA; const char* nB = has_next ? (const char*)g.Bt + (size_t)nxt.pn * tstep : cB;
        for (int t = 0; t < nt; t += 2) {
            const bool last = (t == nt - 2);
            const char* a1 = cA + (size_t)(t + 1) * kstep;
            const char* a2 = last ? nA : cA + (size_t)(t + 2) * kstep; const char* b2 = last ? nB : cB + (size_t)(t + 2) * kstep;
            const char* a3 = a2 + kstep; const char* b3 = b2 + kstep;
            if (last && has_next) S.a_ready(nxt);
            if constexpr (SP2) {
            PG8_LDB(B0, 0, 0); PG8_LDB(B1, 0, 1); PG8_SCHED; PG8_LDA(At, 0, 0); PG8_STAGE(PG8_SA(1, 1), a1 + hstep, voffA);
            PG8_WAIT_V(8); PG8_WAIT_L(0); PG8_BAR; PG8_MMA(0, 0, At, B0); PG8_MMA(0, 1, At, B1); PG8_BAR; PG8_SCHED;
            PG8_LDA(At, 0, 1); PG8_STAGE(PG8_SB(0, 0), b2, voffB); PG8_STAGE(PG8_SB(0, 1), b2 + hstep, voffB); PG8_STAGE(PG8_SA(0, 0), a2, voffA);
            PG8_WAIT_V(8); PG8_WAIT_L(0); PG8_BAR; PG8_MMA(1, 0, At, B0); PG8_MMA(1, 1, At, B1); PG8_BAR; PG8_SCHED;
            PG8_LDB(B0, 1, 0); PG8_LDB(B1, 1, 1); PG8_SCHED; PG8_LDA(At, 1, 0); PG8_STAGE(PG8_SA(0, 1), a2 + hstep, voffA);
            PG8_WAIT_V(8); PG8_WAIT_L(0); PG8_BAR; PG8_MMA(0, 0, At, B0); PG8_MMA(0, 1, At, B1); PG8_BAR; PG8_SCHED;
            PG8_LDA(At, 1, 1); PG8_STAGE(PG8_SB(1, 0), b3, voffB); PG8_STAGE(PG8_SB(1, 1), b3 + hstep, voffB); PG8_STAGE(PG8_SA(1, 0), a3, voffA);
            PG8_WAIT_V(8); PG8_WAIT_L(0); PG8_BAR; PG8_MMA(1, 0, At, B0); PG8_MMA(1, 1, At, B1); PG8_BAR; PG8_SCHED;
            } else {
            PG8_LDB(B0, 0, 0); PG8_SCHED; PG8_LDA(At, 0, 0); PG8_STAGE(PG8_SA(1, 1), a1 + hstep, voffA);
            PG8_WAIT_L(8); PG8_BAR; PG8_WAIT_L(0); PG8_MMA(0, 0, At, B0); PG8_BAR; PG8_SCHED;
            PG8_LDB(B1, 0, 1); PG8_STAGE(PG8_SB(0, 0), b2, voffB);
            PG8_BAR; PG8_WAIT_L(0); PG8_MMA(0, 1, At, B1); PG8_BAR;
            PG8_LDA(At, 0, 1); PG8_STAGE(PG8_SA(0, 0), a2, voffA);
            PG8_BAR; PG8_WAIT_L(0); PG8_MMA(1, 0, At, B0); PG8_BAR; PG8_SCHED;
            PG8_STAGE(PG8_SB(0, 1), b2 + hstep, voffB);
            PG8_WAIT_V(6); PG8_BAR; PG8_MMA(1, 1, At, B1); PG8_BAR;
            PG8_LDB(B0, 1, 0); PG8_SCHED; PG8_LDA(At, 1, 0); PG8_STAGE(PG8_SA(0, 1), a2 + hstep, voffA);
            PG8_WAIT_L(8); PG8_BAR; PG8_WAIT_L(0); PG8_MMA(0, 0, At, B0); PG8_BAR; PG8_SCHED;
            PG8_LDB(B1, 1, 1); PG8_STAGE(PG8_SB(1, 0), b3, voffB);
            PG8_BAR; PG8_WAIT_L(0); PG8_MMA(0, 1, At, B1); PG8_BAR;
            PG8_LDA(At, 1, 1); PG8_STAGE(PG8_SA(1, 0), a3, voffA);
            PG8_BAR; PG8_WAIT_L(0); PG8_MMA(1, 0, At, B0); PG8_BAR; PG8_SCHED;
            PG8_STAGE(PG8_SB(1, 1), b3 + hstep, voffB);
            PG8_WAIT_V(6); PG8_BAR; PG8_MMA(1, 1, At, B1); PG8_BAR;
            }
        }
        if constexpr (ALIGN_EPI) { if (wr == 0) PG8_BAR; }
        if constexpr (!Epi::AFTER_DRAIN) { E(acc, cur, wr, wc, fr, fq); S.done(cur); }
        if (!has_next) break;
#pragma unroll
        for (int a = 0; a < 2; ++a)
#pragma unroll
            for (int b = 0; b < 2; ++b)
#pragma unroll
                for (int m = 0; m < 4; ++m)
#pragma unroll
                    for (int n = 0; n < 2; ++n) acc[a][b][m][n] = (f32x4){0.f, 0.f, 0.f, 0.f};
        cur = nxt; cA = nA; cB = nB; ++ui;
        if constexpr (ALIGN_EPI) { if (wr == 1) PG8_BAR; }
    }
    PG8_WAIT_V(0);
    if constexpr (!ALIGN_EPI) { if (wr == 0) PG8_BAR; }
    PG8_BAR;
    if constexpr (Epi::AFTER_DRAIN) { E.fused(acc, cur, wr, wc, fr, fq, lds, wid, lane); S.done(cur); }
#undef PG8_SA
#undef PG8_SB
#undef PG8_STAGE
#undef PG8_LDA
#undef PG8_LDB
#undef PG8_MMA
#undef PG8_WAIT_V
#undef PG8_WAIT_L
#undef PG8_BAR
#undef PG8_SCHED
}
}
#define LAS __attribute__((address_space(3)))
typedef unsigned short bf16_t;
typedef short bf16x8 __attribute__((ext_vector_type(8)));
typedef short s16x4 __attribute__((ext_vector_type(4)));
typedef float f32x4 __attribute__((ext_vector_type(4)));
typedef float f32x16 __attribute__((ext_vector_type(16)));
typedef unsigned u32x4 __attribute__((ext_vector_type(4)));
typedef unsigned u32x2 __attribute__((ext_vector_type(2)));

constexpr int NB = 8, SEQ = 2048, DM = 2048, MROWS = NB * SEQ;
constexpr int DIN = 7728, NP = 7936;
constexpr int QA_OFF = 0, KCMP_OFF = 1024, VCMP_OFF = 1280, KSLC_OFF = 1536, VSLC_OFF = 1792, KWIN_OFF = 2048, VWIN_OFF = 2304;
constexpr int ZA_OFF = 2560, QH_OFF = 3584, FH_OFF = 4608, IH_OFF = 5632, ZH_OFF = 6656, GATE_OFF = 7680;
constexpr int NCMP = 127;
constexpr float EPSN = 1e-6f;
constexpr float LOG2E = 1.4426950408889634f;
constexpr float QSCALE = 0.125f * LOG2E;
constexpr int NWAVES = 8, NTHREADS = 512;
constexpr int LDS_BYTES = 147456;
constexpr int LDS_CTL = 147456 - 256;

constexpr size_t MiB = 1u << 20;
constexpr size_t WS_CTL = 0;
constexpr size_t WS_W1T = 1 * MiB;
constexpr size_t WS_WOT = 32 * MiB;
constexpr size_t WS_CW1T = 40 * MiB;
constexpr size_t WS_CW2T = 42 * MiB;
constexpr size_t WS_BPE = 42 * MiB + 65536;
constexpr size_t WS_KVC = 43 * MiB;
constexpr size_t WS_RSP = 44 * MiB;
constexpr size_t WS_HB = 48 * MiB;
constexpr size_t WS_MIX = 112 * MiB;
constexpr size_t WS_PROJ = 176 * MiB;
constexpr size_t WS_END = 424 * MiB;

struct Params {
    const float* x; const float* norm_in; const float* w_in; const float* pe_k; const float* w1_k; const float* w2_k;
    const float* pe_v; const float* w1_v; const float* w2_v; const float* lower_bounds; const float* nsa_norm; const float* hgrn_norm;
    const float* w_out; const float* final_norm; float* out; unsigned char* ws; int ph_lo, ph_hi;
};

__device__ __forceinline__ float bf2f(unsigned short h) { return __uint_as_float((unsigned)h << 16); }
__device__ __forceinline__ unsigned cvtpk(float lo, float hi) { return pg8::cvt_pk_bf16(lo, hi); }
__device__ __forceinline__ unsigned short f2bf1(float v) { return (unsigned short)(cvtpk(v, 0.f) & 0xffffu); }
__device__ __forceinline__ float ex2(float v) { return __builtin_amdgcn_exp2f(v); }
__device__ __forceinline__ float lg2(float v) { return __builtin_amdgcn_logf(v); }
__device__ __forceinline__ float rcp(float v) { return __builtin_amdgcn_rcpf(v); }
__device__ __forceinline__ float sigmoidf_(float v) { return rcp(1.f + ex2(-v * LOG2E)); }
__device__ __forceinline__ float siluf_(float v) { return v * sigmoidf_(v); }
__device__ __forceinline__ float wave_sum(float v) {
#pragma unroll
    for (int o = 1; o < 64; o <<= 1) v += __shfl_xor(v, o);
    return v;
}
#define LDS_WAIT() asm volatile("s_waitcnt lgkmcnt(0)" ::: "memory")

struct MapId { __device__ __forceinline__ int operator()(int c) const { return c; } };
struct MapWin { __device__ __forceinline__ int operator()(int c) const { return c < 2560 ? c : (c < 7680 ? c + 48 : (c < 7728 ? c - 7680 + 2560 : -1)); } };
template <class MapF>
__device__ __forceinline__ void p0_transpose_item(const float* W, int K, int Nsrc, bf16_t* WT, LAS float* scr, int item, int nblk, int lane, MapF map) {
    const int kb = item / nblk, nb = item % nblk, k0 = 64 * kb, n0 = 32 * nb;
    const int sc = map(n0 + (lane & 31));
#pragma unroll 8
    for (int i = 0; i < 32; ++i) { const int kk = 2 * i + (lane >> 5); scr[kk * 33 + (lane & 31)] = sc >= 0 ? W[(size_t)(k0 + kk) * Nsrc + sc] : 0.f; }
    LDS_WAIT(); asm volatile("" ::: "memory");
    const int c = lane & 7;
#pragma unroll
    for (int j = 0; j < 4; ++j) { const int n = (lane >> 3) + 8 * j; const LAS float* s = scr + (8 * c) * 33 + n;
        u32x4 o; o.x = cvtpk(s[0 * 33], s[1 * 33]); o.y = cvtpk(s[2 * 33], s[3 * 33]); o.z = cvtpk(s[4 * 33], s[5 * 33]); o.w = cvtpk(s[6 * 33], s[7 * 33]);
        *(u32x4*)(WT + (size_t)(n0 + n) * K + k0 + 8 * c) = o; }
    LDS_WAIT(); asm volatile("" ::: "memory");
}
__device__ __forceinline__ void rms_row_to_bf16(const float* xrow, const float* g, bf16_t* orow, int lane) {
    const f32x4* xr = (const f32x4*)xrow + lane; const f32x4* gr = (const f32x4*)g + lane;
    f32x4 v[8]; float s = 0.f;
#pragma unroll
    for (int j = 0; j < 8; ++j) { v[j] = xr[64 * j]; s += (v[j].x * v[j].x + v[j].y * v[j].y) + (v[j].z * v[j].z + v[j].w * v[j].w); }
    const float rstd = __builtin_amdgcn_rsqf(wave_sum(s) * (1.f / DM) + EPSN);
    u32x2* o8 = (u32x2*)orow + lane;
#pragma unroll
    for (int j = 0; j < 8; ++j) { const f32x4 gg = gr[64 * j]; u32x2 w; w.x = cvtpk(v[j].x * rstd * gg.x, v[j].y * rstd * gg.y); w.y = cvtpk(v[j].z * rstd * gg.z, v[j].w * rstd * gg.w); o8[64 * j] = w; }
}
__device__ __forceinline__ void phase0(const Params& P, LAS unsigned char* lds, int G) {
    const int tid = threadIdx.x, lane = tid & 63, wave = __builtin_amdgcn_readfirstlane(tid >> 6);
    unsigned char* ws = P.ws;
    bf16_t* W1T = (bf16_t*)(ws + WS_W1T); bf16_t* WOT = (bf16_t*)(ws + WS_WOT); bf16_t* CW1T = (bf16_t*)(ws + WS_CW1T); bf16_t* CW2T = (bf16_t*)(ws + WS_CW2T);
    bf16_t* HB = (bf16_t*)(ws + WS_HB); float* BPE = (float*)(ws + WS_BPE);
    LAS float* scr = (LAS float*)(lds + wave * 16384);
    const int gw = blockIdx.x * NWAVES + wave, NGW = G * NWAVES;
    constexpr int I_IN = 32 * (NP / 32), I_OUT = 32 * (DM / 32), I_C1 = 32 * 8, I_C2 = 4 * 2;
    constexpr int NITEMS = I_IN + I_OUT + 2 * I_C1 + 2 * I_C2;
    for (int it = gw; it < NITEMS; it += NGW) {
        int r = it;
        if (r < I_IN) { p0_transpose_item(P.w_in, DM, DIN, W1T, scr, r, NP / 32, lane, MapWin()); continue; } r -= I_IN;
        if (r < I_OUT) { p0_transpose_item(P.w_out, DM, DM, WOT, scr, r, DM / 32, lane, MapId()); continue; } r -= I_OUT;
        if (r < I_C1) { p0_transpose_item(P.w1_k, 2048, 256, CW1T, scr, r, 8, lane, MapId()); continue; } r -= I_C1;
        if (r < I_C1) { p0_transpose_item(P.w1_v, 2048, 256, CW1T + 256 * 2048, scr, r, 8, lane, MapId()); continue; } r -= I_C1;
        if (r < I_C2) { p0_transpose_item(P.w2_k, 256, 64, CW2T, scr, r, 2, lane, MapId()); continue; } r -= I_C2;
        p0_transpose_item(P.w2_v, 256, 64, CW2T + 64 * 256, scr, r, 2, lane, MapId());
    }
    for (int m = gw; m < MROWS; m += NGW) rms_row_to_bf16(P.x + (size_t)m * DM, P.norm_in, HB + (size_t)m * DM, lane);
    __syncthreads();
    for (int u = blockIdx.x; u < 32; u += G) {
        const int kv = u >> 4, part = u & 15; const float* pe = kv ? P.pe_v : P.pe_k; const float* w1 = kv ? P.w1_v : P.w1_k;
        const int n = tid & 255, kh = tid >> 8; float s = 0.f;
#pragma unroll 8
        for (int i = 0; i < 64; ++i) { const int k = part * 128 + kh * 64 + i; s += pe[k] * w1[(size_t)k * 256 + n]; }
        LAS float* red = (LAS float*)lds;
        __syncthreads();
        if (kh) red[n] = s;
        __syncthreads();
        if (!kh) BPE[(kv * 16 + part) * 256 + n] = s + red[n];
        __syncthreads();
    }
}

__device__ __forceinline__ float gelu_tanh(float v) {
    const float u = 0.7978845608028654f * (v + 0.044715f * v * v * v);
    const float e = ex2(u * (2.f * LOG2E));
    const float th = 1.f - 2.f * rcp(1.f + e);
    return 0.5f * v * (1.f + th);
}
__device__ __forceinline__ void phase2(const Params& P, LAS unsigned char* lds, int G) {
    const int tid = threadIdx.x, lane = tid & 63, wave = __builtin_amdgcn_readfirstlane(tid >> 6), fr = lane & 15, fq = lane >> 4;
    unsigned char* ws = P.ws;
    const bf16_t* PROJ = (const bf16_t*)(ws + WS_PROJ); const bf16_t* CW1T = (const bf16_t*)(ws + WS_CW1T); const bf16_t* CW2T = (const bf16_t*)(ws + WS_CW2T);
    const float* BPE = (const float*)(ws + WS_BPE); bf16_t* KVC = (bf16_t*)(ws + WS_KVC);
    constexpr int XB = 0, HBO = 528 * 128;
    for (int u = blockIdx.x; u < 256; u += G) {
        const int kv = u >> 7, rem = u & 127, b = rem >> 4, g = (rem >> 2) & 3, n0 = 32 * (rem & 3);
        const bf16_t* src = PROJ + (size_t)b * SEQ * NP + (kv ? VCMP_OFF : KCMP_OFF) + g * 64;
        __syncthreads();
        for (int p = tid; p < 528 * 8; p += NTHREADS) { const int tok = p >> 3, c = p & 7; int t = 16 * n0 + tok; t = t < SEQ ? t : SEQ - 1;
            const u32x4 v = *(const u32x4*)(src + (size_t)t * NP + c * 8);
            *(LAS u32x4*)(lds + XB + tok * 128 + ((c ^ ((tok >> 4) & 7)) * 16)) = v; }
        __syncthreads();
        const bf16_t* w1t = CW1T + (size_t)kv * 256 * 2048;
        f32x4 acc[2][2];
#pragma unroll
        for (int a = 0; a < 2; ++a)
#pragma unroll
            for (int c = 0; c < 2; ++c) acc[a][c] = (f32x4){0.f, 0.f, 0.f, 0.f};
        const bf16_t* bp0 = w1t + (size_t)(32 * wave + fr) * 2048 + 8 * fq;
        const bf16_t* bp1 = bp0 + 16 * 2048;
#pragma unroll 4
        for (int ks = 0; ks < 64; ++ks) {
            const int l = ks >> 1, c = (ks & 1) * 4 + fq;
            const bf16x8 b0 = *(const bf16x8*)(bp0 + ks * 32), b1 = *(const bf16x8*)(bp1 + ks * 32);
            const int tok0 = 16 * fr + l, tok1 = 16 * (16 + fr) + l;
            const bf16x8 a0 = *(const LAS bf16x8*)(lds + XB + tok0 * 128 + ((c ^ ((tok0 >> 4) & 7)) * 16));
            const bf16x8 a1 = *(const LAS bf16x8*)(lds + XB + tok1 * 128 + ((c ^ ((tok1 >> 4) & 7)) * 16));
            acc[0][0] = __builtin_amdgcn_mfma_f32_16x16x32_bf16(a0, b0, acc[0][0], 0, 0, 0);
            acc[0][1] = __builtin_amdgcn_mfma_f32_16x16x32_bf16(a0, b1, acc[0][1], 0, 0, 0);
            acc[1][0] = __builtin_amdgcn_mfma_f32_16x16x32_bf16(a1, b0, acc[1][0], 0, 0, 0);
            acc[1][1] = __builtin_amdgcn_mfma_f32_16x16x32_bf16(a1, b1, acc[1][1], 0, 0, 0);
        }
#pragma unroll
        for (int nb = 0; nb < 2; ++nb) { const int hid = 32 * wave + 16 * nb + fr; float bias = 0.f;
#pragma unroll
            for (int p = 0; p < 16; ++p) bias += BPE[(kv * 16 + p) * 256 + hid];
#pragma unroll
            for (int mb = 0; mb < 2; ++mb)
#pragma unroll
                for (int r = 0; r < 4; ++r) { const int nl = 16 * mb + 4 * fq + r; *(LAS unsigned short*)(lds + HBO + nl * 528 + hid * 2) = f2bf1(gelu_tanh(acc[mb][nb][r] + bias)); } }
        __syncthreads();
        const bf16_t* w2t = CW2T + (size_t)kv * 64 * 256; const int mb = wave >> 2, nb = wave & 3;
        f32x4 o = (f32x4){0.f, 0.f, 0.f, 0.f};
#pragma unroll
        for (int ks = 0; ks < 8; ++ks) {
            const bf16x8 a = *(const LAS bf16x8*)(lds + HBO + (16 * mb + fr) * 528 + (32 * ks + 8 * fq) * 2);
            const bf16x8 bb = *(const bf16x8*)(w2t + (size_t)(16 * nb + fr) * 256 + 32 * ks + 8 * fq);
            o = __builtin_amdgcn_mfma_f32_16x16x32_bf16(a, bb, o, 0, 0, 0);
        }
        bf16_t* dst = KVC + ((size_t)((kv * NB + b) * 4 + g) * 128) * 64;
#pragma unroll
        for (int r = 0; r < 4; ++r) { const int n = n0 + 16 * mb + 4 * fq + r; dst[(size_t)n * 64 + 16 * nb + fr] = (n < NCMP) ? f2bf1(o[r]) : (unsigned short)0; }
    }
}
namespace hg {
constexpr int RS = 272;
constexpr int TS = 144;
constexpr int OS = 528;
constexpr int QS = 0, QE = QS + 64 * RS, KE = QE + 64 * RS, KLT = KE + 64 * RS, VT = KLT + 128 * TS, PP = VT + 128 * TS, OST = PP + 64 * TS, TOT = OST + 64 * OS, DEC = TOT + 4 * 128 * 4, END = DEC + 128 * 4;
static_assert(END <= LDS_CTL, "hgrn LDS map");
}
__device__ __forceinline__ void hgrn_unit(const Params& P, LAS unsigned char* lds, int unit) {
    using namespace hg;
    int tid_ = threadIdx.x; asm volatile("" : "+v"(tid_));
    const int tid = tid_, lane = tid & 63, wave = __builtin_amdgcn_readfirstlane(tid >> 6), fr = lane & 15, fq = lane >> 4;
    const int b = unit >> 3, h = unit & 7;
    unsigned char* ws = P.ws;
    const bf16_t* PROJ = (const bf16_t*)(ws + WS_PROJ); bf16_t* MIX = (bf16_t*)(ws + WS_MIX);
    const int d = tid & 127, sg = tid >> 7;
    float lb; { const float a = P.lower_bounds[h * 128 + d], bb = P.lower_bounds[1024 + h * 128 + d]; lb = rcp(1.f + ex2((bb - a) * LOG2E)); }
    f32x4 S[8];
#pragma unroll
    for (int i = 0; i < 8; ++i) S[i] = (f32x4){0.f, 0.f, 0.f, 0.f};
    const int et = tid >> 3, ec = tid & 7;
    f32x4 gain[4];
#pragma unroll
    for (int i = 0; i < 4; ++i) gain[i] = *(const f32x4*)(P.hgrn_norm + h * 128 + 16 * ec + 4 * i);
    for (int c = 0; c < 32; ++c) {
        const size_t row0 = (size_t)b * SEQ + c * 64;
        {
            const bf16_t* src = PROJ + (row0 + 16 * sg) * NP + h * 128 + d;
            unsigned short qraw[16], fraw[16], vraw[16];
#pragma unroll
            for (int i = 0; i < 16; ++i) { qraw[i] = src[(size_t)i * NP + QH_OFF]; fraw[i] = src[(size_t)i * NP + FH_OFF]; vraw[i] = src[(size_t)i * NP + IH_OFF]; }
            float kk[16], bl[16]; float run = 0.f;
#pragma unroll
            for (int i = 0; i < 16; ++i) { const float f = lb + (1.f - lb) * sigmoidf_(bf2f(fraw[i])); kk[i] = 1.f - f; run += lg2(f); bl[i] = run; }
            *(LAS float*)(lds + TOT + (sg * 128 + d) * 4) = run;
            __syncthreads();
            const float t0 = *(LAS float*)(lds + TOT + (0 * 128 + d) * 4), t1 = *(LAS float*)(lds + TOT + (1 * 128 + d) * 4), t2 = *(LAS float*)(lds + TOT + (2 * 128 + d) * 4), t3 = *(LAS float*)(lds + TOT + (3 * 128 + d) * 4);
            const float off = (sg > 0 ? t0 : 0.f) + (sg > 1 ? t1 : 0.f) + (sg > 2 ? t2 : 0.f);
            const float bmid = t0 + t1, ball = (t0 + t1) + (t2 + t3);
            unsigned klp[8], vp[8];
#pragma unroll
            for (int i = 0; i < 16; i += 2) {
                float klv[2];
#pragma unroll
                for (int j = 0; j < 2; ++j) { const int s = 16 * sg + i + j; const float bb = off + bl[i + j]; const float q = bf2f(qraw[i + j]);
                    *(LAS unsigned short*)(lds + QS + s * RS + d * 2) = f2bf1(q * ex2(bb));
                    *(LAS unsigned short*)(lds + QE + s * RS + d * 2) = f2bf1(q * ex2(bb - bmid));
                    *(LAS unsigned short*)(lds + KE + s * RS + d * 2) = f2bf1(kk[i + j] * ex2(bmid - bb));
                    klv[j] = kk[i + j] * ex2(ball - bb); }
                klp[i >> 1] = cvtpk(klv[0], klv[1]); vp[i >> 1] = (unsigned)vraw[i] | ((unsigned)vraw[i + 1] << 16);
            }
            *(LAS u32x4*)(lds + KLT + d * TS + sg * 32) = (u32x4){klp[0], klp[1], klp[2], klp[3]};
            *(LAS u32x4*)(lds + KLT + d * TS + sg * 32 + 16) = (u32x4){klp[4], klp[5], klp[6], klp[7]};
            *(LAS u32x4*)(lds + VT + d * TS + sg * 32) = (u32x4){vp[0], vp[1], vp[2], vp[3]};
            *(LAS u32x4*)(lds + VT + d * TS + sg * 32 + 16) = (u32x4){vp[4], vp[5], vp[6], vp[7]};
            if (sg == 0) *(LAS float*)(lds + DEC + d * 4) = ex2(ball);
        }
        __syncthreads();
        {
            const int tb = wave & 3, sh = wave >> 2;
#pragma unroll
            for (int sbi = 0; sbi < 2; ++sbi) { const int sb = 2 * sh + sbi;
                if (sb <= tb) {
                    f32x4 a = (f32x4){0.f, 0.f, 0.f, 0.f};
#pragma unroll
                    for (int st = 0; st < 4; ++st) {
                        const bf16x8 ka = *(const LAS bf16x8*)(lds + KE + (16 * sb + fr) * RS + (32 * st + 8 * fq) * 2);
                        const bf16x8 qb = *(const LAS bf16x8*)(lds + QE + (16 * tb + fr) * RS + (32 * st + 8 * fq) * 2);
                        a = __builtin_amdgcn_mfma_f32_16x16x32_bf16(ka, qb, a, 0, 0, 0);
                    }
                    const int t = 16 * tb + fr, s0 = 16 * sb + 4 * fq;
                    const float v0 = (s0 + 0 <= t) ? a[0] : 0.f, v1 = (s0 + 1 <= t) ? a[1] : 0.f, v2 = (s0 + 2 <= t) ? a[2] : 0.f, v3 = (s0 + 3 <= t) ? a[3] : 0.f;
                    *(LAS u32x2*)(lds + PP + t * TS + s0 * 2) = (u32x2){cvtpk(v0, v1), cvtpk(v2, v3)};
                } else if (2 * sh <= tb) {
                    const int t = 16 * tb + fr, s0 = 16 * sb + 4 * fq;
                    *(LAS u32x2*)(lds + PP + t * TS + s0 * 2) = (u32x2){0u, 0u};
                }
            }
        }
        __syncthreads();
        {
            bf16x8 vf[2];
#pragma unroll
            for (int i = 0; i < 2; ++i) vf[i] = *(const LAS bf16x8*)(lds + VT + (16 * wave + fr) * TS + (32 * i + 8 * fq) * 2);
            bf16x8 sb16[4];
#pragma unroll
            for (int st = 0; st < 4; ++st) { const unsigned w0 = cvtpk(S[2 * st][0], S[2 * st][1]), w1 = cvtpk(S[2 * st][2], S[2 * st][3]), w2 = cvtpk(S[2 * st + 1][0], S[2 * st + 1][1]), w3 = cvtpk(S[2 * st + 1][2], S[2 * st + 1][3]);
                sb16[st] = __builtin_bit_cast(bf16x8, (u32x4){w0, w1, w2, w3}); }
#pragma unroll
            for (int tb = 0; tb < 4; ++tb) {
                f32x4 o = (f32x4){0.f, 0.f, 0.f, 0.f};
#pragma unroll
                for (int st = 0; st < 4; ++st) {
                    const u32x2 lo = *(const LAS u32x2*)(lds + QS + (16 * tb + fr) * RS + (32 * st + 4 * fq) * 2);
                    const u32x2 hi = *(const LAS u32x2*)(lds + QS + (16 * tb + fr) * RS + (32 * st + 16 + 4 * fq) * 2);
                    const bf16x8 qa = __builtin_bit_cast(bf16x8, (u32x4){lo.x, lo.y, hi.x, hi.y});
                    o = __builtin_amdgcn_mfma_f32_16x16x32_bf16(qa, sb16[st], o, 0, 0, 0);
                }
#pragma unroll
                for (int i = 0; i < 2; ++i) if (2 * i <= tb) {
                    const bf16x8 pa = *(const LAS bf16x8*)(lds + PP + (16 * tb + fr) * TS + (32 * i + 8 * fq) * 2);
                    o = __builtin_amdgcn_mfma_f32_16x16x32_bf16(pa, vf[i], o, 0, 0, 0);
                }
#pragma unroll
                for (int r = 0; r < 4; ++r) *(LAS float*)(lds + OST + (16 * tb + 4 * fq + r) * OS + (16 * wave + fr) * 4) = o[r];
            }
#pragma unroll
            for (int db = 0; db < 8; ++db) {
                const f32x4 dc = *(const LAS f32x4*)(lds + DEC + (16 * db + 4 * fq) * 4);
                S[db] = S[db] * dc;
#pragma unroll
                for (int i = 0; i < 2; ++i) {
                    const bf16x8 ka = *(const LAS bf16x8*)(lds + KLT + (16 * db + fr) * TS + (32 * i + 8 * fq) * 2);
                    S[db] = __builtin_amdgcn_mfma_f32_16x16x32_bf16(ka, vf[i], S[db], 0, 0, 0);
                }
            }
        }
        __syncthreads();
        {
            f32x4 ov[4]; float ss = 0.f;
#pragma unroll
            for (int i = 0; i < 4; ++i) { ov[i] = *(const LAS f32x4*)(lds + OST + et * OS + (16 * ec + 4 * i) * 4); ss += (ov[i].x * ov[i].x + ov[i].y * ov[i].y) + (ov[i].z * ov[i].z + ov[i].w * ov[i].w); }
            ss += __shfl_xor(ss, 1); ss += __shfl_xor(ss, 2); ss += __shfl_xor(ss, 4);
            const float rstd = __builtin_amdgcn_rsqf(ss * (1.f / 128.f) + EPSN);
            const bf16_t* zp = PROJ + (row0 + et) * NP + ZH_OFF + h * 128 + 16 * ec;
            const u32x4 z0 = *(const u32x4*)zp, z1 = *(const u32x4*)(zp + 8);
            const unsigned zw[8] = {z0.x, z0.y, z0.z, z0.w, z1.x, z1.y, z1.z, z1.w};
            unsigned ow[8];
#pragma unroll
            for (int i = 0; i < 8; ++i) { const float za = __uint_as_float(zw[i] << 16), zb = __uint_as_float(zw[i] & 0xffff0000u);
                const float oa = ov[i >> 1][(2 * i) & 3] * rstd * gain[i >> 1][(2 * i) & 3] * siluf_(za);
                const float ob = ov[i >> 1][(2 * i + 1) & 3] * rstd * gain[i >> 1][(2 * i + 1) & 3] * siluf_(zb);
                ow[i] = cvtpk(oa, ob); }
            bf16_t* op = MIX + (row0 + et) * DM + 1024 + h * 128 + 16 * ec;
            *(u32x4*)op = (u32x4){ow[0], ow[1], ow[2], ow[3]}; *(u32x4*)(op + 8) = (u32x4){ow[4], ow[5], ow[6], ow[7]};
        }
    }
    __syncthreads();
}
namespace at {
constexpr int KB0 = 0, KB1 = 8192, VB0 = 16384, VB1 = 24576, PS4 = 32768, SELM = PS4 + 4 * 64 * 33 * 4, UNI = SELM + 256, TL = UNI + 64, TLN = TL + 64 * 4, OAC = TLN + 64, END = OAC + 8 * 8192;
static_assert(END <= LDS_CTL, "attention LDS map");
}
typedef short v4i16_t __attribute__((ext_vector_type(4)));
__device__ __forceinline__ s16x4 vtr(const LAS unsigned char* p) { return __builtin_bit_cast(s16x4, __builtin_amdgcn_ds_read_tr16_b64_v4i16((LAS v4i16_t*)p)); }
__device__ __forceinline__ float xhalf(float v) { return __shfl_xor(v, 32); }

__device__ __forceinline__ void kv_load(u32x4& kr, u32x4& vr, const bf16_t* kbase, const bf16_t* vbase, int pitch, int wave, int lane) {
    kr = *(const u32x4*)(kbase + (size_t)lane * pitch + wave * 8);
    vr = *(const u32x4*)(vbase + (size_t)(16 * (wave & 3) + (lane >> 2)) * pitch + (wave >> 2) * 32 + (lane & 3) * 8);
}
__device__ __forceinline__ void kv_store(const u32x4& kr, const u32x4& vr, LAS unsigned char* kslot, LAS unsigned char* vslot, int wave, int lane) {
    *(LAS u32x4*)(kslot + wave * 1024 + lane * 16) = kr;
    *(LAS u32x4*)(vslot + wave * 1024 + lane * 16) = vr;
}
__device__ __forceinline__ void qkt(f32x16& p0, f32x16& p1, const LAS unsigned char* kslot, const bf16x8 (&qr)[4], int r32, int hi) {
    const LAS unsigned char* kb = kslot + hi * 1024 + r32 * 16;
    p0 = (f32x16){0.f, 0.f, 0.f, 0.f, 0.f, 0.f, 0.f, 0.f, 0.f, 0.f, 0.f, 0.f, 0.f, 0.f, 0.f, 0.f}; p1 = p0;
#pragma unroll
    for (int d0 = 0; d0 < 4; ++d0) {
        const bf16x8 b0 = *(const LAS bf16x8*)(kb + d0 * 2048), b1 = *(const LAS bf16x8*)(kb + d0 * 2048 + 512);
        p0 = __builtin_amdgcn_mfma_f32_32x32x16_bf16(b0, qr[d0], p0, 0, 0, 0);
        p1 = __builtin_amdgcn_mfma_f32_32x32x16_bf16(b1, qr[d0], p1, 0, 0, 0);
    }
}
__device__ __forceinline__ void pv(f32x16 (&o)[2], const LAS unsigned char* vslot, const f32x16& p0, const f32x16& p1, int lane) {
    const int hi = lane >> 5;
    const LAS unsigned char* vb = vslot + ((lane >> 4) & 1) * 32 + (lane & 3) * 8 + (4 * hi + ((lane & 15) >> 2)) * 64;
    bf16x8 pb[4];
#pragma unroll
    for (int s = 0; s < 2; ++s) {
        pb[s] = __builtin_bit_cast(bf16x8, (u32x4){cvtpk(p0[8 * s + 0], p0[8 * s + 1]), cvtpk(p0[8 * s + 2], p0[8 * s + 3]), cvtpk(p0[8 * s + 4], p0[8 * s + 5]), cvtpk(p0[8 * s + 6], p0[8 * s + 7])});
        pb[2 + s] = __builtin_bit_cast(bf16x8, (u32x4){cvtpk(p1[8 * s + 0], p1[8 * s + 1]), cvtpk(p1[8 * s + 2], p1[8 * s + 3]), cvtpk(p1[8 * s + 4], p1[8 * s + 5]), cvtpk(p1[8 * s + 6], p1[8 * s + 7])});
    }
#pragma unroll
    for (int d0 = 0; d0 < 2; ++d0)
#pragma unroll
        for (int ks = 0; ks < 4; ++ks) {
            const s16x4 lo = vtr(vb + d0 * 4096 + ks * 1024), hh = vtr(vb + d0 * 4096 + ks * 1024 + 512);
            const bf16x8 vf = (bf16x8){lo[0], lo[1], lo[2], lo[3], hh[0], hh[1], hh[2], hh[3]};
            o[d0] = __builtin_amdgcn_mfma_f32_32x32x16_bf16(vf, pb[ks], o[d0], 0, 0, 0);
        }
}
__device__ __forceinline__ void tile_step(f32x16 (&o)[2], float& m, float& l, const LAS unsigned char* kslot, const LAS unsigned char* vslot, const bf16x8 (&qr)[4],
                                          float sl, float ub, bool boundary, int dl1, unsigned rng, int lane) {
    const int r32 = lane & 31, hi = lane >> 5;
    f32x16 p0, p1;
    qkt(p0, p1, kslot, qr, r32, hi);
    if (boundary) {
#pragma unroll
        for (int r = 0; r < 16; ++r) { const int c = (r & 3) + 8 * (r >> 2) + 4 * hi;
            p0[r] = ((unsigned)(c - dl1) <= rng) ? p0[r] : -INFINITY; p1[r] = ((unsigned)(c + 32 - dl1) <= rng) ? p1[r] : -INFINITY; }
    }
    const float sl4 = sl * (float)(4 * hi);
    float mx = -INFINITY;
#pragma unroll
    for (int r = 0; r < 16; ++r) { const float cf = (float)((r & 3) + 8 * (r >> 2));
        p0[r] = fmaf(sl, cf, p0[r]); p1[r] = fmaf(sl, cf + 32.f, p1[r]); mx = fmaxf(mx, fmaxf(p0[r], p1[r])); }
    const float ubl = ub + sl4;
    mx = mx + ubl; mx = fmaxf(mx, xhalf(mx));
    const float mn = fmaxf(m, mx), alpha = ex2(m - mn); m = mn;
    const float sub = mn - ubl;
    float sum = 0.f;
#pragma unroll
    for (int r = 0; r < 16; ++r) { p0[r] = ex2(p0[r] - sub); p1[r] = ex2(p1[r] - sub); sum += p0[r] + p1[r]; }
    l = l * alpha + sum;
#pragma unroll
    for (int r = 0; r < 16; ++r) { o[0][r] *= alpha; o[1][r] *= alpha; }
    pv(o, vslot, p0, p1, lane);
}

__device__ __forceinline__ void attn_unit(const Params& P, LAS unsigned char* lds, int unit) {
    using namespace at;
    int tid_ = threadIdx.x; asm volatile("" : "+v"(tid_));
    const int tid = tid_, lane = tid & 63, wave = __builtin_amdgcn_readfirstlane(tid >> 6), r32 = lane & 31, hi = lane >> 5;
    const int b = unit >> 7, g = (unit >> 5) & 3, qt = unit & 31, t0 = qt * 64;
    const int hr = wave >> 1, th = wave & 1, hq = 4 * g + hr;
    const int tq = t0 + 32 * th + r32;
    unsigned char* ws = P.ws;
    const bf16_t* PROJ = (const bf16_t*)(ws + WS_PROJ); bf16_t* MIX = (bf16_t*)(ws + WS_MIX); const bf16_t* KVC = (const bf16_t*)(ws + WS_KVC);
    const size_t brow = (size_t)b * SEQ;
    const float sl = ex2(-0.5f * (float)(hq + 1)) * LOG2E;
    const bf16_t* qp = PROJ + (brow + tq) * NP + QA_OFF + hq * 64;
    bf16x8 qr[4];
#pragma unroll
    for (int d0 = 0; d0 < 4; ++d0) qr[d0] = *(const bf16x8*)(qp + d0 * 16 + hi * 8);
    float gate[3];
#pragma unroll
    for (int i = 0; i < 3; ++i) gate[i] = sigmoidf_(bf2f(PROJ[(brow + tq) * NP + GATE_OFF + hq * 3 + i]));

#if defined(EXPORT_BR)
    float* OBX = (float*)(ws + 424 * MiB) + (brow + tq) * 1024 + hq * 64;
#define EXPORT_O(OO, SCL) do { _Pragma("unroll") for (int d0_ = 0; d0_ < 2; ++d0_) _Pragma("unroll") for (int r_ = 0; r_ < 16; ++r_) OBX[32 * d0_ + (r_ & 3) + 8 * (r_ >> 2) + 4 * hi] = OO[d0_][r_] * (SCL); } while (0)
#endif
    f32x16 oacc[2];
    __syncthreads();
    {
        const bf16_t* kc = KVC + ((size_t)((0 * NB + b) * 4 + g) * 128) * 64; const bf16_t* vc = KVC + ((size_t)((1 * NB + b) * 4 + g) * 128) * 64;
        u32x4 k0, v0, k1, v1;
        kv_load(k0, v0, kc, vc, 64, wave, lane); kv_load(k1, v1, kc + 64 * 64, vc + 64 * 64, 64, wave, lane);
        kv_store(k0, v0, lds + KB0, lds + VB0, wave, lane); kv_store(k1, v1, lds + KB1, lds + VB1, wave, lane);
        if (tid < 64) *(LAS unsigned*)(lds + SELM + tid * 4) = 0u;
        if (tid == 64) *(LAS unsigned*)(lds + UNI) = 0u;
    }
    __syncthreads();
    {
        f32x16 s[4];
        qkt(s[0], s[1], lds + KB0, qr, r32, hi); qkt(s[2], s[3], lds + KB1, qr, r32, hi);
        int nmax = (tq - 31) >> 4; nmax = nmax < (NCMP - 1) ? nmax : (NCMP - 1);
        const float sl16 = 16.f * sl; float mx = -INFINITY;
#pragma unroll
        for (int bi = 0; bi < 4; ++bi)
#pragma unroll
            for (int r = 0; r < 16; ++r) { const int n = 32 * bi + (r & 3) + 8 * (r >> 2) + 4 * hi;
                s[bi][r] = (n <= nmax) ? s[bi][r] + sl16 * (float)(n - 4 * qt) : -INFINITY; mx = fmaxf(mx, s[bi][r]); }
        mx = fmaxf(mx, xhalf(mx));
        const float mm = fmaxf(mx, -1e30f);
        float sum = 0.f;
#pragma unroll
        for (int bi = 0; bi < 4; ++bi)
#pragma unroll
            for (int r = 0; r < 16; ++r) { s[bi][r] = ex2(s[bi][r] - mm); sum += s[bi][r]; }
        sum += xhalf(sum);
        const float inv = sum > 0.f ? rcp(sum) : 0.f;
        float A[16], Bv[16];
#pragma unroll
        for (int bi = 0; bi < 4; ++bi)
#pragma unroll
            for (int i = 0; i < 4; ++i) { const float h3 = 0.5f * s[bi][4 * i + 3]; A[4 * bi + i] = ((s[bi][4 * i] + s[bi][4 * i + 1]) + s[bi][4 * i + 2]) + h3; Bv[4 * bi + i] = h3; }
        LAS float* ps = (LAS float*)(lds + PS4) + (hr * 64 + 32 * th + r32) * 33;
#pragma unroll
        for (int e = 0; e < 16; ++e) {
            const float other = xhalf(Bv[e]);
            const float otherprev = e > 0 ? xhalf(Bv[e - 1]) : 0.f;
            const float add = hi ? other : otherprev;
            ps[2 * e + hi] = (A[e] + add) * inv;
        }
        oacc[0] = (f32x16){0.f, 0.f, 0.f, 0.f, 0.f, 0.f, 0.f, 0.f, 0.f, 0.f, 0.f, 0.f, 0.f, 0.f, 0.f, 0.f}; oacc[1] = oacc[0];
        pv(oacc, lds + VB0, s[0], s[1], lane); pv(oacc, lds + VB1, s[2], s[3], lane);
#if defined(EXPORT_BR) && EXPORT_BR == 0
        EXPORT_O(oacc, inv);
#endif
        const float sc = inv * gate[0];
#pragma unroll
        for (int r = 0; r < 16; ++r) { *(LAS float*)(lds + OAC + wave * 8192 + r * 256 + lane * 4) = oacc[0][r] * sc; *(LAS float*)(lds + OAC + wave * 8192 + (16 + r) * 256 + lane * 4) = oacc[1][r] * sc; }
    }
    __syncthreads();
    {
        const int tok = tid & 63, jg = tid >> 6; const int t = t0 + tok, cur = t >> 6;
        const LAS float* p4 = (const LAS float*)(lds + PS4) + tok * 33;
        float sc[32];
#pragma unroll
        for (int j = 0; j < 32; ++j) { const float p = ((p4[j] + p4[64 * 33 + j]) + p4[2 * 64 * 33 + j]) + p4[3 * 64 * 33 + j];
            const bool forced = (j == 0) || (j == cur) || (j == cur - 1);
            sc[j] = (j > cur) ? -1.f : p + (forced ? 1.0e4f : 0.f); }
        unsigned bits = 0u;
#pragma unroll
        for (int jj = 0; jj < 4; ++jj) {
            float mine = 0.f;
#pragma unroll
            for (int j = 0; j < 32; ++j) mine = (j == 4 * jg + jj) ? sc[j] : mine;
            const int jme = 4 * jg + jj; int cnt = 0;
#pragma unroll
            for (int i = 0; i < 32; ++i) cnt += ((sc[i] > mine) || (sc[i] == mine && i < jme)) ? 1 : 0;
            if (cnt < 8 && jme <= cur) bits |= 1u << jme;
        }
        if (bits) { __hip_atomic_fetch_or((LAS unsigned*)(lds + SELM + tok * 4), bits, __ATOMIC_RELAXED, __HIP_MEMORY_SCOPE_WORKGROUP); __hip_atomic_fetch_or((LAS unsigned*)(lds + UNI), bits, __ATOMIC_RELAXED, __HIP_MEMORY_SCOPE_WORKGROUP); }
    }
    __syncthreads();
    if (tid == 0) {
        unsigned u = *(LAS unsigned*)(lds + UNI); int n = 0;
        while (u) { const int j = __builtin_ctz(u); u &= u - 1; *(LAS int*)(lds + TL + 4 * n) = j; ++n; }
        const int w0 = qt >= 8 ? qt - 8 : 0;
        for (int j = w0; j <= qt; ++j) { *(LAS int*)(lds + TL + 4 * n) = 64 + j; ++n; }
        *(LAS int*)(lds + TLN) = n;
    }
    __syncthreads();
    {
        const int ntile = __builtin_amdgcn_readfirstlane(*(LAS int*)(lds + TLN));
        const unsigned selmask = *(LAS unsigned*)(lds + SELM + (32 * th + r32) * 4);
#if defined(EXPORT_SEL)
        if (hr == 0 && hi == 0) ((unsigned*)(ws + 490 * MiB))[(b * 4 + g) * SEQ + tq] = selmask;
#endif
        const bf16_t* ks_base = PROJ + brow * NP + KSLC_OFF + g * 64; const bf16_t* vs_base = PROJ + brow * NP + VSLC_OFF + g * 64;
        const bf16_t* kw_base = PROJ + brow * NP + KWIN_OFF + g * 64; const bf16_t* vw_base = PROJ + brow * NP + VWIN_OFF + g * 64;
        f32x16 o[2]; o[0] = (f32x16){0.f, 0.f, 0.f, 0.f, 0.f, 0.f, 0.f, 0.f, 0.f, 0.f, 0.f, 0.f, 0.f, 0.f, 0.f, 0.f}; o[1] = o[0];
        float m = -1e30f, l = 0.f; int prev_win = 0;
        u32x4 kr, vr;
        { const int e = __builtin_amdgcn_readfirstlane(*(LAS int*)(lds + TL)); const int win = e >> 6, j = e & 63;
          kv_load(kr, vr, (win ? kw_base : ks_base) + (size_t)(64 * j) * NP, (win ? vw_base : vs_base) + (size_t)(64 * j) * NP, NP, wave, lane);
          kv_store(kr, vr, lds + KB0, lds + VB0, wave, lane); }
        __syncthreads();
        for (int i = 0; i < ntile; ++i) {
            const int e = __builtin_amdgcn_readfirstlane(*(LAS int*)(lds + TL + 4 * i)); const int win = e >> 6, j = e & 63;
            if (i + 1 < ntile) { const int e2 = __builtin_amdgcn_readfirstlane(*(LAS int*)(lds + TL + 4 * (i + 1))); const int win2 = e2 >> 6, j2 = e2 & 63;
                kv_load(kr, vr, (win2 ? kw_base : ks_base) + (size_t)(64 * j2) * NP, (win2 ? vw_base : vs_base) + (size_t)(64 * j2) * NP, NP, wave, lane); }
            if (win != prev_win) {
                const float lt = l + xhalf(l); const float sc = (lt > 0.f ? rcp(lt) : 0.f) * gate[1];
#if defined(EXPORT_BR) && EXPORT_BR == 1
                EXPORT_O(o, (lt > 0.f ? rcp(lt) : 0.f));
#endif
#pragma unroll
                for (int r = 0; r < 16; ++r) { LAS float* a0 = (LAS float*)(lds + OAC + wave * 8192 + r * 256 + lane * 4); LAS float* a1 = (LAS float*)(lds + OAC + wave * 8192 + (16 + r) * 256 + lane * 4);
                    *a0 = *a0 + o[0][r] * sc; *a1 = *a1 + o[1][r] * sc; o[0][r] = 0.f; o[1][r] = 0.f; }
                m = -1e30f; l = 0.f; prev_win = win;
            }
            const bool flag = win ? true : (((selmask >> j) & 1u) != 0u);
            const int kpos0 = 64 * j;
            const float ub = flag ? sl * (float)(kpos0 - t0) : -INFINITY;
            const bool boundary = win ? (j == qt || j + 8 == qt) : (j == qt);
            const int lo = win ? tq - 512 : -1;
            const int dl1 = lo + 1 - kpos0; const unsigned rng = (unsigned)(tq - lo - 1);
            const LAS unsigned char* ksl = lds + KB0 + (i & 1) * 8192; const LAS unsigned char* vsl = lds + VB0 + (i & 1) * 8192;
            tile_step(o, m, l, ksl, vsl, qr, sl, ub, boundary, dl1, rng, lane);
            if (i + 1 < ntile) kv_store(kr, vr, lds + KB0 + ((i + 1) & 1) * 8192, lds + VB0 + ((i + 1) & 1) * 8192, wave, lane);
            __syncthreads();
        }
        { const float lt = l + xhalf(l); const float sc = (lt > 0.f ? rcp(lt) : 0.f) * gate[2];
#if defined(EXPORT_BR) && EXPORT_BR == 2
          EXPORT_O(o, (lt > 0.f ? rcp(lt) : 0.f));
#endif
#pragma unroll
          for (int r = 0; r < 16; ++r) { oacc[0][r] = *(LAS float*)(lds + OAC + wave * 8192 + r * 256 + lane * 4) + o[0][r] * sc; oacc[1][r] = *(LAS float*)(lds + OAC + wave * 8192 + (16 + r) * 256 + lane * 4) + o[1][r] * sc; } }
    }
    {
        float ss = 0.f;
#pragma unroll
        for (int r = 0; r < 16; ++r) ss += oacc[0][r] * oacc[0][r] + oacc[1][r] * oacc[1][r];
        ss += xhalf(ss);
        const float rstd = __builtin_amdgcn_rsqf(ss * (1.f / 64.f) + EPSN);
        const bf16_t* zp = PROJ + (brow + tq) * NP + ZA_OFF + hq * 64; bf16_t* op = MIX + (brow + tq) * DM + hq * 64; const float* gp = P.nsa_norm + hq * 64;
#pragma unroll
        for (int d0 = 0; d0 < 2; ++d0)
#pragma unroll
            for (int q4 = 0; q4 < 4; ++q4) { const int dd = 32 * d0 + 8 * q4 + 4 * hi;
                const u32x2 z = *(const u32x2*)(zp + dd); const f32x4 gg = *(const f32x4*)(gp + dd);
                const float z0 = __uint_as_float(z.x << 16), z1 = __uint_as_float(z.x & 0xffff0000u), z2 = __uint_as_float(z.y << 16), z3 = __uint_as_float(z.y & 0xffff0000u);
                const float y0 = oacc[d0][4 * q4 + 0] * rstd * gg.x * siluf_(z0), y1 = oacc[d0][4 * q4 + 1] * rstd * gg.y * siluf_(z1);
                const float y2 = oacc[d0][4 * q4 + 2] * rstd * gg.z * siluf_(z2), y3 = oacc[d0][4 * q4 + 3] * rstd * gg.w * siluf_(z3);
                *(u32x2*)(op + dd) = (u32x2){cvtpk(y0, y1), cvtpk(y2, y3)}; }
    }
}
#if defined(NAIVE_HGRN)
__device__ __forceinline__ void hgrn_unit_naive(const Params& P, LAS unsigned char* lds, int unit) {
    int tid_ = threadIdx.x; asm volatile("" : "+v"(tid_)); const int tid = tid_; const int b = unit >> 3, h = unit & 7;
    const bf16_t* PROJ = (const bf16_t*)(P.ws + WS_PROJ); bf16_t* MIX = (bf16_t*)(P.ws + WS_MIX);
    LAS float* S = (LAS float*)lds;
    LAS float* QV = S + 128 * 129; LAS float* FV = QV + 128; LAS float* KV = FV + 128; LAS float* VV = KV + 128; LAS float* PART = VV + 128; LAS float* RED = PART + 512;
    const int e = tid & 127, dq = tid >> 7;
    for (int i = tid; i < 128 * 129; i += NTHREADS) S[i] = 0.f;
    float lb = 0.f; if (tid < 128) { const float a = P.lower_bounds[h * 128 + tid], bb = P.lower_bounds[1024 + h * 128 + tid]; lb = 1.f / (1.f + expf(bb - a)); }
    __syncthreads();
    for (int t = 0; t < SEQ; ++t) {
        const size_t row = (size_t)b * SEQ + t;
        if (tid < 128) { const bf16_t* src = PROJ + row * NP + h * 128 + tid; const float q = bf2f(src[QH_OFF]), fp = bf2f(src[FH_OFF]), v = bf2f(src[IH_OFF]);
            const float f = lb + (1.f - lb) * (1.f / (1.f + expf(-fp))); QV[tid] = q; FV[tid] = f; KV[tid] = 1.f - f; VV[tid] = v; }
        __syncthreads();
        float part = 0.f; const float ve = VV[e];
        for (int d = dq * 32; d < dq * 32 + 32; ++d) { const float s = FV[d] * S[d * 129 + e] + KV[d] * ve; S[d * 129 + e] = s; part += QV[d] * s; }
        PART[dq * 128 + e] = part;
        __syncthreads();
        if (tid < 128) { const float o = (PART[tid] + PART[128 + tid]) + (PART[256 + tid] + PART[384 + tid]);
            float ss = o * o; ss = wave_sum(ss); if ((tid & 63) == 0) RED[tid >> 6] = ss; }
        __syncthreads();
        if (tid < 128) { const float o = (PART[tid] + PART[128 + tid]) + (PART[256 + tid] + PART[384 + tid]); const float ss = RED[0] + RED[1];
            const float rstd = 1.f / sqrtf(ss / 128.f + EPSN); const float z = bf2f(PROJ[row * NP + ZH_OFF + h * 128 + tid]);
            MIX[row * DM + 1024 + h * 128 + tid] = f2bf1(o * rstd * P.hgrn_norm[h * 128 + tid] * (z / (1.f + expf(-z)))); }
    }
    __syncthreads();
}
#endif
#if defined(NAIVE_CMP)
__device__ __forceinline__ void phase2_naive(const Params& P, LAS unsigned char* lds, int G) {
    int tid_ = threadIdx.x; asm volatile("" : "+v"(tid_)); const int tid = tid_; const bf16_t* PROJ = (const bf16_t*)(P.ws + WS_PROJ); bf16_t* KVC = (bf16_t*)(P.ws + WS_KVC);
    LAS float* X = (LAS float*)lds; LAS float* Hd = X + 2048; LAS float* PR = Hd + 256;
    for (int u = blockIdx.x; u < 2 * NB * 4 * 128; u += G) {
        const int kv = u >> 12, b = (u >> 9) & 7, g = (u >> 7) & 3, n = u & 127;
        bf16_t* dst = KVC + ((size_t)((kv * NB + b) * 4 + g) * 128 + n) * 64;
        __syncthreads();
        if (n >= NCMP) { if (tid < 64) dst[tid] = 0; continue; }
        const float* pe = kv ? P.pe_v : P.pe_k; const float* w1 = kv ? P.w1_v : P.w1_k; const float* w2 = kv ? P.w2_v : P.w2_k;
        for (int k = tid; k < 2048; k += NTHREADS) { const int l = k >> 6, d = k & 63; X[k] = bf2f(PROJ[((size_t)b * SEQ + 16 * n + l) * NP + (kv ? VCMP_OFF : KCMP_OFF) + g * 64 + d]) + pe[k]; }
        __syncthreads();
        { const int hid = tid & 255, kh = tid >> 8; float s = 0.f; for (int k = kh * 1024; k < kh * 1024 + 1024; ++k) s += X[k] * w1[(size_t)k * 256 + hid]; PR[kh * 256 + hid] = s; }
        __syncthreads();
        if (tid < 256) { const float v = PR[tid] + PR[256 + tid]; const float uu = 0.7978845608028654f * (v + 0.044715f * v * v * v); Hd[tid] = 0.5f * v * (1.f + tanhf(uu)); }
        __syncthreads();
        if (tid < 64) { float s = 0.f; for (int k = 0; k < 256; ++k) s += Hd[k] * w2[k * 64 + tid]; dst[tid] = f2bf1(s); }
    }
}
#endif
#if defined(NAIVE_ATTN) || defined(EXPORT_SEL) || defined(EXPORT_BR)
__device__ __forceinline__ float dot64(const LAS float* q, const bf16_t* k) {
    float s = 0.f;
#pragma unroll
    for (int c = 0; c < 8; ++c) { const u32x4 w = *(const u32x4*)(k + 8 * c); const unsigned ww[4] = {w.x, w.y, w.z, w.w};
#pragma unroll
        for (int i = 0; i < 4; ++i) { s += q[(8 * c + 2 * i) * 256] * __uint_as_float(ww[i] << 16); s += q[(8 * c + 2 * i + 1) * 256] * __uint_as_float(ww[i] & 0xffff0000u); } }
    return s;
}
__device__ __forceinline__ void axpy64(float (&o)[64], float p, const bf16_t* v) {
#pragma unroll
    for (int c = 0; c < 8; ++c) { const u32x4 w = *(const u32x4*)(v + 8 * c); const unsigned ww[4] = {w.x, w.y, w.z, w.w};
#pragma unroll
        for (int i = 0; i < 4; ++i) { o[8 * c + 2 * i] += p * __uint_as_float(ww[i] << 16); o[8 * c + 2 * i + 1] += p * __uint_as_float(ww[i] & 0xffff0000u); } }
}
__device__ __forceinline__ void attn_unit_naive(const Params& P, LAS unsigned char* lds, int unit) {
    int tid_ = threadIdx.x; asm volatile("" : "+v"(tid_)); const int tid = tid_;
    const int b = unit >> 7, g = (unit >> 5) & 3, qt = unit & 31, t0 = qt * 64;
    const bf16_t* PROJ = (const bf16_t*)(P.ws + WS_PROJ); bf16_t* MIX = (bf16_t*)(P.ws + WS_MIX); const bf16_t* KVC = (const bf16_t*)(P.ws + WS_KVC);
    if (tid >= 256) return;
    const int tok = tid >> 2, r = tid & 3, hq = 4 * g + r, t = t0 + tok; const size_t brow = (size_t)b * SEQ;
    const float sl = ex2(-0.5f * (float)(hq + 1)) * LOG2E;
    LAS float* q = (LAS float*)lds + 64 * 256 + tid;
    { const bf16_t* qp = PROJ + (brow + t) * NP + QA_OFF + hq * 64;
#pragma unroll
      for (int d = 0; d < 64; ++d) q[d * 256] = bf2f(qp[d]); }
    float gate[3];
#pragma unroll
    for (int i = 0; i < 3; ++i) { const float gv = bf2f(PROJ[(brow + t) * NP + GATE_OFF + hq * 3 + i]); gate[i] = 1.f / (1.f + expf(-gv)); }
    LAS float* oacc = (LAS float*)lds + tid;
#pragma unroll
    for (int d = 0; d < 64; ++d) oacc[d * 256] = 0.f;
    const bf16_t* kc = KVC + ((size_t)((0 * NB + b) * 4 + g) * 128) * 64; const bf16_t* vc = KVC + ((size_t)((1 * NB + b) * 4 + g) * 128) * 64;
    int nval = 0; if (t >= 31) { nval = ((t - 31) >> 4) + 1; if (nval > NCMP) nval = NCMP; }
    float mc = -INFINITY, lc = 0.f;
    for (int n = 0; n < nval; ++n) { const float s = dot64(q, kc + n * 64) + sl * (float)(16 * n - t0); mc = fmaxf(mc, s); }
    { float o[64];
#pragma unroll
      for (int d = 0; d < 64; ++d) o[d] = 0.f;
      for (int n = 0; n < nval; ++n) { const float s = dot64(q, kc + n * 64) + sl * (float)(16 * n - t0); const float p = exp2f(s - mc); lc += p; axpy64(o, p, vc + n * 64); }
      float sc = lc > 0.f ? gate[0] / lc : 0.f;
#if defined(EXPORT_BR) && EXPORT_BR == 0
      { const float* ob = (const float*)(P.ws + 424 * MiB) + (brow + t) * 1024 + hq * 64; _Pragma("unroll") for (int d = 0; d < 64; ++d) o[d] = ob[d]; sc = gate[0]; }
#endif
#pragma unroll
      for (int d = 0; d < 64; ++d) oacc[d * 256] += o[d] * sc; }
    const int cur = t >> 6; unsigned selmask = 0u;
    { float sc[32];
#pragma unroll
      for (int j = 0; j < 32; ++j) { float acc = 0.f;
#pragma unroll
          for (int i = -1; i < 4; ++i) { const int n = 4 * j + i; const float w = (i == -1 || i == 3) ? 0.5f : 1.f;
              float p = 0.f; if (n >= 0 && n < nval) p = exp2f(dot64(q, kc + n * 64) + sl * (float)(16 * n - t0) - mc) / lc;
              acc += w * p; }
          acc += __shfl_xor(acc, 1); acc += __shfl_xor(acc, 2);
          const bool forced = (j == 0) || (j == cur) || (j == cur - 1);
          sc[j] = (j > cur) ? -1.f : acc + (forced ? 1.0e4f : 0.f); }
#pragma unroll
      for (int j = 0; j < 32; ++j) { int cnt = 0;
#pragma unroll
          for (int i = 0; i < 32; ++i) cnt += ((sc[i] > sc[j]) || (sc[i] == sc[j] && i < j)) ? 1 : 0;
          if (cnt < 8 && j <= cur) selmask |= 1u << j; } }
#if defined(EXPORT_SEL)
    selmask = ((const unsigned*)(P.ws + 490 * MiB))[(b * 4 + g) * SEQ + t];
#endif
    { float o[64]; float m = -INFINITY, l = 0.f;
#pragma unroll
      for (int d = 0; d < 64; ++d) o[d] = 0.f;
      for (int j = 0; j < 32; ++j) { if (!((selmask >> j) & 1u)) continue;
          for (int i = 0; i < 64; ++i) { const int pos = 64 * j + i; if (pos > t) break;
              const bf16_t* kp = PROJ + (brow + pos) * NP + KSLC_OFF + g * 64; const bf16_t* vp = PROJ + (brow + pos) * NP + VSLC_OFF + g * 64;
              const float s = dot64(q, kp) + sl * (float)(pos - t0); const float mn = fmaxf(m, s); const float al = exp2f(m - mn), p = exp2f(s - mn); m = mn; l = l * al + p;
#pragma unroll
              for (int d = 0; d < 64; ++d) o[d] *= al;
              axpy64(o, p, vp); } }
      float sc = l > 0.f ? gate[1] / l : 0.f;
#if defined(EXPORT_BR) && EXPORT_BR == 1
      { const float* ob = (const float*)(P.ws + 424 * MiB) + (brow + t) * 1024 + hq * 64; _Pragma("unroll") for (int d = 0; d < 64; ++d) o[d] = ob[d]; sc = gate[1]; }
#endif
#pragma unroll
      for (int d = 0; d < 64; ++d) oacc[d * 256] += o[d] * sc; }
    { float o[64]; float m = -INFINITY, l = 0.f;
#pragma unroll
      for (int d = 0; d < 64; ++d) o[d] = 0.f;
      const int p0 = t - 511 > 0 ? t - 511 : 0;
      for (int pos = p0; pos <= t; ++pos) {
          const bf16_t* kp = PROJ + (brow + pos) * NP + KWIN_OFF + g * 64; const bf16_t* vp = PROJ + (brow + pos) * NP + VWIN_OFF + g * 64;
          const float s = dot64(q, kp) + sl * (float)(pos - t0); const float mn = fmaxf(m, s); const float al = exp2f(m - mn), p = exp2f(s - mn); m = mn; l = l * al + p;
#pragma unroll
          for (int d = 0; d < 64; ++d) o[d] *= al;
          axpy64(o, p, vp); }
      float sc = l > 0.f ? gate[2] / l : 0.f;
#if defined(EXPORT_BR) && EXPORT_BR == 2
      { const float* ob = (const float*)(P.ws + 424 * MiB) + (brow + t) * 1024 + hq * 64; _Pragma("unroll") for (int d = 0; d < 64; ++d) o[d] = ob[d]; sc = gate[2]; }
#endif
#pragma unroll
      for (int d = 0; d < 64; ++d) oacc[d * 256] += o[d] * sc; }
    float ss = 0.f;
#pragma unroll
    for (int d = 0; d < 64; ++d) ss += oacc[d * 256] * oacc[d * 256];
    const float rstd = 1.f / sqrtf(ss / 64.f + EPSN);
#pragma unroll
    for (int d = 0; d < 64; ++d) { const float z = bf2f(PROJ[(brow + t) * NP + ZA_OFF + hq * 64 + d]);
        MIX[(brow + t) * DM + hq * 64 + d] = f2bf1(oacc[d * 256] * rstd * P.nsa_norm[hq * 64 + d] * (z / (1.f + expf(-z)))); }
}
#endif
__device__ __forceinline__ void phase5(const Params& P, int G) {
    const int tid = threadIdx.x, lane = tid & 63, wave = __builtin_amdgcn_readfirstlane(tid >> 6);
    const float* RSP = (const float*)(P.ws + WS_RSP);
    const int gw = blockIdx.x * NWAVES + wave, NGW = G * NWAVES;
    for (int m = gw; m < MROWS; m += NGW) {
        float* row = P.out + (size_t)m * DM;
        f32x4 v[8];
#pragma unroll
        for (int j = 0; j < 8; ++j) v[j] = ((const f32x4*)row)[64 * j + lane];
        float s = lane < 32 ? RSP[(size_t)lane * MROWS + m] : 0.f;
        const float rstd = __builtin_amdgcn_rsqf(wave_sum(s) * (1.f / DM) + EPSN);
#pragma unroll
        for (int j = 0; j < 8; ++j) { const f32x4 gg = ((const f32x4*)P.final_norm)[64 * j + lane]; ((f32x4*)row)[64 * j + lane] = v[j] * rstd * gg; }
    }
}

constexpr int N_HGRN = 64, N_ATTN = 1024;
__global__ void __launch_bounds__(NTHREADS, 2) hymba_fwd(Params P) {
    extern __shared__ __attribute__((aligned(16))) unsigned char lds_raw[];
    LAS unsigned char* lds = (LAS unsigned char*)lds_raw;
    const int G = gridDim.x;
    const int lo = P.ph_lo, hi = P.ph_hi;
#define IN(k) (lo <= (k) && (k) < hi)
#define SEAM(k) do { if (IN(k) && IN((k) + 1)) { cg::this_grid().sync(); } } while (0)
    unsigned char* ws = P.ws;
    #if !defined(ONLY) || ONLY==0
    if (IN(0)) { phase0(P, lds, G); }
#endif
    SEAM(0);
#if !defined(ONLY) || ONLY==1
    if (IN(1)) {
        pg8::Gemm g{(const pg8::bf16_t*)(ws + WS_HB), (const pg8::bf16_t*)(ws + WS_W1T), MROWS, NP, DM}; pg8::StaticOrder S; S.init(MROWS, NP, G, (int)blockIdx.x);
        pg8::EpiProj E{(pg8::bf16_t*)(ws + WS_PROJ), NP, 4, QSCALE};
        pg8::gemm_phase<pg8::EpiProj, pg8::StaticOrder, true, true>(lds, g, S, E);
    }
#endif
    SEAM(1);
#if !defined(ONLY) || ONLY==2
#if defined(NAIVE_CMP)
    if (IN(2)) { phase2_naive(P, lds, G); }
#else
    if (IN(2)) { phase2(P, lds, G); }
#endif
#endif
    SEAM(2);
#if !defined(ONLY) || ONLY==3 || ONLY==30 || ONLY==31
    if (IN(3)) {
        unsigned* qctr = (unsigned*)(ws + WS_CTL);
        for (;;) {
            __syncthreads();
            if (threadIdx.x == 0) *(LAS unsigned*)(lds + LDS_CTL) = atomicAdd(qctr, 1u);
            __syncthreads();
            const int item = (int)__builtin_amdgcn_readfirstlane(*(LAS unsigned*)(lds + LDS_CTL));
            if (item >= N_HGRN + N_ATTN) break;
#if defined(ONLY) && ONLY==30
            hgrn_unit(P, lds, item & 63);
#elif defined(ONLY) && ONLY==31
            attn_unit(P, lds, item & 1023);
#else
#if defined(EXPORT_SEL) || defined(EXPORT_BR)
            if (item < N_HGRN) hgrn_unit(P, lds, item); else attn_unit(P, lds, item - N_HGRN);
#elif defined(NAIVE_ATTN)
            if (item < N_HGRN) hgrn_unit(P, lds, item); else attn_unit_naive(P, lds, item - N_HGRN);
#elif defined(NAIVE_HGRN)
            if (item < N_HGRN) hgrn_unit_naive(P, lds, item); else attn_unit(P, lds, item - N_HGRN);
#else
            if (item < N_HGRN) hgrn_unit(P, lds, item); else attn_unit(P, lds, item - N_HGRN);
#endif
#endif
        }
    }
#endif
    SEAM(3);
#if defined(EXPORT_SEL) || defined(EXPORT_BR)
    if (IN(6)) { for (int u = blockIdx.x; u < N_ATTN; u += G) { __syncthreads(); attn_unit_naive(P, lds, u); } }
#endif
#if !defined(ONLY) || ONLY==4
    if (IN(4)) {
        pg8::Gemm g{(const pg8::bf16_t*)(ws + WS_MIX), (const pg8::bf16_t*)(ws + WS_WOT), MROWS, DM, DM}; pg8::StaticOrder S; S.init(MROWS, DM, G, (int)blockIdx.x);
        pg8::EpiRes E{P.x, P.out, DM, (float*)(ws + WS_RSP), MROWS};
        pg8::gemm_phase<pg8::EpiRes, pg8::StaticOrder, true, true>(lds, g, S, E);
    }
#endif
    SEAM(4);
#if !defined(ONLY) || ONLY==5
    if (IN(5)) { phase5(P, G); }
#endif
#undef IN
#undef SEAM
}

extern "C" void kernel_launch(void* const* d_in, const int* in_sizes, int n_in, void* d_out, int out_size, void* d_ws, size_t ws_size, hipStream_t stream) {
    static int grid = 0;
    if (grid == 0) {
        if (n_in != 14 || in_sizes[0] != MROWS * DM || out_size != MROWS * DM || ws_size < WS_END) { fprintf(stderr, "kernel_launch: unexpected shapes (n_in %d, in0 %d, out %d, ws %zu)\n", n_in, n_in > 0 ? in_sizes[0] : -1, out_size, ws_size); grid = -1; return; }
        int dev = 0, cus = 0, per_cu = 0;
        if (hipGetDevice(&dev) != hipSuccess || hipDeviceGetAttribute(&cus, hipDeviceAttributeMultiprocessorCount, dev) != hipSuccess) { grid = -1; return; }
        if (hipFuncSetAttribute((const void*)hymba_fwd, hipFuncAttributeMaxDynamicSharedMemorySize, LDS_BYTES) != hipSuccess) { fprintf(stderr, "kernel_launch: hipFuncSetAttribute failed\n"); grid = -1; return; }
        if (hipOccupancyMaxActiveBlocksPerMultiprocessor(&per_cu, (const void*)hymba_fwd, NTHREADS, LDS_BYTES) != hipSuccess || per_cu < 1) { fprintf(stderr, "kernel_launch: occupancy query says %d blocks per CU\n", per_cu); per_cu = 1; }
        (void)hipGetLastError();
        grid = cus;
    }
    if (grid < 0) return;
    (void)hipMemsetAsync((char*)d_ws + WS_CTL, 0, 4096, stream);
    Params p{};
    p.x = (const float*)d_in[0]; p.norm_in = (const float*)d_in[1]; p.w_in = (const float*)d_in[2]; p.pe_k = (const float*)d_in[3]; p.w1_k = (const float*)d_in[4]; p.w2_k = (const float*)d_in[5];
    p.pe_v = (const float*)d_in[6]; p.w1_v = (const float*)d_in[7]; p.w2_v = (const float*)d_in[8]; p.lower_bounds = (const float*)d_in[9]; p.nsa_norm = (const float*)d_in[10]; p.hgrn_norm = (const float*)d_in[11];
    p.w_out = (const float*)d_in[12]; p.final_norm = (const float*)d_in[13]; p.out = (float*)d_out; p.ws = (unsigned char*)d_ws;
#if MK_LAUNCHES == 1
    p.ph_lo = 0; p.ph_hi = 6;
    void* args[] = {&p};
    hipError_t e = hipLaunchCooperativeKernel((const void*)hymba_fwd, dim3(grid), dim3(NTHREADS), args, LDS_BYTES, stream);
    if (e != hipSuccess) fprintf(stderr, "kernel_launch: cooperative launch failed: %s (grid %d)\n", hipGetErrorString(e), grid);
#else
    for (int ph = 0; ph < 6; ++ph) { p.ph_lo = ph; p.ph_hi = ph + 1; hipLaunchKernelGGL(hymba_fwd, dim3(grid), dim3(NTHREADS), LDS_BYTES, stream, p);
#if defined(EXPORT_SEL) || defined(EXPORT_BR)
        if (ph == 3) { p.ph_lo = 6; p.ph_hi = 7; hipLaunchKernelGGL(hymba_fwd, dim3(grid), dim3(NTHREADS), LDS_BYTES, stream, p); }
#endif
    }
#endif
}
```

```cpp
#include <hip/hip_runtime.h>
#include <hip/hip_cooperative_groups.h>
#include <cstdio>
#include <cstdint>
namespace cg = cooperative_groups;

#ifndef MK_LAUNCHES
#define MK_LAUNCHES 1
#endif
namespace pg8 {
#define PG8_LAS __attribute__((address_space(3)))
typedef unsigned short bf16_t;
typedef short bf16x8 __attribute__((ext_vector_type(8)));
typedef float f32x4 __attribute__((ext_vector_type(4)));
typedef unsigned u32x4 __attribute__((ext_vector_type(4)));
constexpr int BM = 256, BK = 64, HALF = 128, HTB = HALF * BK * 2  , STAGE_BYTES = 8 * HTB, NXCD = 8, WGM = 8;

__host__ __device__ __forceinline__ int lds_byte(int r, int c) { const int st = (r >> 4) * 2 + (c >> 5), rr = r & 15, cc = c & 31, ob = rr * 64 + cc * 2; return st * 1024 + (ob ^ (((ob >> 9) & 1) << 5)); }
__host__ __device__ __forceinline__ void stage_rc(int b, int& R, int& C) { const int st = b / 1024, sb = b % 1024, swz = sb ^ (((sb >> 9) & 1) << 5); R = (st >> 1) * 16 + swz / 64; C = (st & 1) * 32 + (swz % 64) / 2; }
__host__ __device__ __forceinline__ int perm32(int rho) { const int n = rho >> 4, i = rho & 15; return 8 * (i >> 2) + 4 * n + (i & 3); }

struct Unit { int pm, pn; };
struct Gemm { const bf16_t* A; const bf16_t* Bt; int M, N, K; };

struct StaticOrder {
    int nM, nN, nwg, G, c;
    __host__ __device__ void init(int M, int N, int G_, int c_) { nM = M / BM; nN = N / BM; nwg = nM * nN; G = G_; c = c_; }
    __host__ __device__ bool next(int i, Unit& u) const {
        const long L = (long)i * G + c; if (L >= nwg) return false;
        int wgid = (int)L; { const int q = nwg / NXCD, r = nwg % NXCD, xcd = wgid % NXCD, off = wgid / NXCD; wgid = (xcd < r ? xcd * (q + 1) : r * (q + 1) + (xcd - r) * q) + off; }
        const int nig = WGM * nN, gid = wgid / nig, fm = gid * WGM, gsz = (nM - fm) < WGM ? (nM - fm) : WGM;
        u.pm = fm + ((wgid % nig) % gsz); u.pn = (wgid % nig) / gsz; return true;
    }
    __device__ __forceinline__ void a_ready(const Unit&) const {}
    __device__ __forceinline__ void done(const Unit&) const {}
};

typedef float f32x2 __attribute__((ext_vector_type(2)));
typedef __bf16 bf16x2_t __attribute__((ext_vector_type(2)));
__device__ __forceinline__ unsigned cvt_pk_bf16(float lo, float hi) { f32x2 v = {lo, hi}; bf16x2_t b = __builtin_convertvector(v, bf16x2_t); return __builtin_bit_cast(unsigned, b); }

struct EpiProj {
    static constexpr bool PERM = true, AFTER_DRAIN = false;
    bf16_t* O; int ldc; int nq; float qscale;
    __device__ __forceinline__ void operator()(const f32x4 (&acc)[2][2][4][2], const Unit& u, int wr, int wc, int fr, int fq) const {
        const int row0 = u.pm * BM + wr * 64 + fr; const int col0 = u.pn * BM + wc * 32 + 8 * fq;
        const float sc = (u.pn < nq) ? qscale : 1.f;
#pragma unroll
        for (int ai = 0; ai < 2; ++ai)
#pragma unroll
            for (int m = 0; m < 4; ++m) { bf16_t* rowp = O + (size_t)(row0 + ai * HALF + m * 16) * ldc + col0;
#pragma unroll
                for (int bj = 0; bj < 2; ++bj) { const f32x4 v0 = acc[ai][bj][m][0] * sc, v1 = acc[ai][bj][m][1] * sc;
                    u32x4 w; w.x = cvt_pk_bf16(v0[0], v0[1]); w.y = cvt_pk_bf16(v0[2], v0[3]); w.z = cvt_pk_bf16(v1[0], v1[1]); w.w = cvt_pk_bf16(v1[2], v1[3]);
                    *(u32x4*)(rowp + bj * HALF) = w; } }
    }
};
struct EpiRes {
    static constexpr bool PERM = false, AFTER_DRAIN = false;
    const float* base; float* out; int ldc; float* part; int M;
    __device__ __forceinline__ void operator()(const f32x4 (&acc)[2][2][4][2], const Unit& u, int wr, int wc, int fr, int fq) const {
        const int col0 = u.pn * BM + wc * 32 + 4 * fq;
#pragma unroll
        for (int ai = 0; ai < 2; ++ai)
#pragma unroll
            for (int m = 0; m < 4; ++m) { const int r = u.pm * BM + ai * HALF + wr * 64 + m * 16 + fr; const size_t off = (size_t)r * ldc + col0; float ss = 0.f;
#pragma unroll
                for (int bj = 0; bj < 2; ++bj)
#pragma unroll
                    for (int n = 0; n < 2; ++n) { const f32x4 bs = *(const f32x4*)(base + off + bj * HALF + n * 16); const f32x4 y = bs + acc[ai][bj][m][n];
                        *(f32x4*)(out + off + bj * HALF + n * 16) = y; ss += (y[0] * y[0] + y[1] * y[1]) + (y[2] * y[2] + y[3] * y[3]); }
                ss += __shfl_xor(ss, 16); ss += __shfl_xor(ss, 32);
                if (fq == 0) part[(size_t)(4 * u.pn + wc) * M + r] = ss; }
    }
};
template <class Epi, class Sched, bool ALIGN_EPI = false, bool SP2 = false>
__device__ __forceinline__ void gemm_phase(PG8_LAS unsigned char* lds, const Gemm g, const Sched& S, const Epi& E) {
    const int tid = threadIdx.x, wid = __builtin_amdgcn_readfirstlane(tid >> 6), lane = tid & 63, wr = wid >> 2, wc = wid & 3, fr = lane & 15, fq = lane >> 4;
    const int K = g.K, nt = K / BK;
    unsigned voffA[2], voffB[2];
#pragma unroll
    for (int i = 0; i < 2; ++i) { int R, C; stage_rc(tid * 16 + i * 8192, R, C); const int Rb = Epi::PERM ? ((R & ~31) + perm32(R & 31)) : R;
        voffA[i] = (unsigned)(R * K + C) * 2u; voffB[i] = (unsigned)(Rb * K + C) * 2u; }
    const size_t kstep = (size_t)(BK * 2);
    const size_t hstep = (size_t)HALF * K * 2;
    const size_t tstep = 2 * hstep;
    const unsigned ldsw = (unsigned)wid * 1024u;
    const int aoff = lds_byte(wr * 64 + fr, fq * 8), boff = lds_byte(wc * 32 + fr, fq * 8);
#define PG8_SA(b, h) (((b) * 2 + (h)) * HTB)
#define PG8_SB(b, h) ((4 + (b) * 2 + (h)) * HTB)
#define PG8_STAGE(bufoff, gbase, voff) do { _Pragma("unroll") for (int _i = 0; _i < 2; ++_i) \
        __builtin_amdgcn_global_load_lds((const unsigned*)((const char*)(gbase) + (voff)[_i]), (PG8_LAS unsigned*)(lds + (bufoff) + ldsw + _i * 8192), 16, 0, 0); } while (0)
#define PG8_LDA(dst, b, h) do { _Pragma("unroll") for (int m = 0; m < 4; ++m) _Pragma("unroll") for (int k = 0; k < 2; ++k) dst[m][k] = *(const PG8_LAS bf16x8*)(lds + PG8_SA(b, h) + aoff + m * 2048 + k * 1024); } while (0)
#define PG8_LDB(dst, b, h) do { _Pragma("unroll") for (int n = 0; n < 2; ++n) _Pragma("unroll") for (int k = 0; k < 2; ++k) dst[n][k] = *(const PG8_LAS bf16x8*)(lds + PG8_SB(b, h) + boff + n * 2048 + k * 1024); } while (0)
#define PG8_MMA(ai, bj, At, Bt) do { __builtin_amdgcn_s_setprio(1); _Pragma("unroll") for (int m = 0; m < 4; ++m) _Pragma("unroll") for (int n = 0; n < 2; ++n) _Pragma("unroll") for (int k = 0; k < 2; ++k) \
        acc[ai][bj][m][n] = __builtin_amdgcn_mfma_f32_16x16x32_bf16(Bt[n][k], At[m][k], acc[ai][bj][m][n], 0, 0, 0); __builtin_amdgcn_s_setprio(0); } while (0)
#define PG8_WAIT_V(n) asm volatile("s_waitcnt vmcnt(" #n ")" ::: "memory")
#define PG8_WAIT_L(n) asm volatile("s_waitcnt lgkmcnt(" #n ")" ::: "memory")
#define PG8_BAR __builtin_amdgcn_s_barrier()
#define PG8_SCHED __builtin_amdgcn_sched_barrier(0)
    Unit cur, nxt; int ui = 0;
    if (!S.next(0, cur)) return;
    f32x4 acc[2][2][4][2];
#pragma unroll
    for (int a = 0; a < 2; ++a)
#pragma unroll
        for (int b = 0; b < 2; ++b)
#pragma unroll
            for (int m = 0; m < 4; ++m)
#pragma unroll
                for (int n = 0; n < 2; ++n) acc[a][b][m][n] = (f32x4){0.f, 0.f, 0.f, 0.f};
    bf16x8 At[4][2], B0[2][2], B1[2][2];
    const char* cA = (const char*)g.A + (size_t)cur.pm * tstep; const char* cB = (const char*)g.Bt + (size_t)cur.pn * tstep;
    S.a_ready(cur);
    if constexpr (SP2) {
        PG8_STAGE(PG8_SB(0, 0), cB, voffB); PG8_STAGE(PG8_SB(0, 1), cB + hstep, voffB); PG8_STAGE(PG8_SA(0, 0), cA, voffA); PG8_STAGE(PG8_SA(0, 1), cA + hstep, voffA);
        if (wr == 1) PG8_BAR;
        PG8_WAIT_V(2); PG8_BAR;
        PG8_STAGE(PG8_SB(1, 0), cB + kstep, voffB); PG8_STAGE(PG8_SA(1, 0), cA + kstep, voffA); PG8_STAGE(PG8_SB(1, 1), cB + hstep + kstep, voffB);
        PG8_WAIT_V(6); PG8_BAR;
    } else {
        PG8_STAGE(PG8_SB(0, 0), cB, voffB); PG8_STAGE(PG8_SA(0, 0), cA, voffA); PG8_STAGE(PG8_SB(0, 1), cB + hstep, voffB); PG8_STAGE(PG8_SA(0, 1), cA + hstep, voffA);
        if (wr == 1) PG8_BAR;
        PG8_WAIT_V(4); PG8_BAR;
        PG8_STAGE(PG8_SB(1, 0), cB + kstep, voffB); PG8_STAGE(PG8_SA(1, 0), cA + kstep, voffA); PG8_STAGE(PG8_SB(1, 1), cB + hstep + kstep, voffB);
        PG8_WAIT_V(6); PG8_BAR;
    }
    for (;;) {
        const bool has_next = S.next(ui + 1, nxt);
        const char* nA = has_next ? (const char*)g.A + (size_t)nxt.pm * tstep : cA; const char* nB = has_next ? (const char*)g.Bt + (size_t)nxt.pn * tstep : cB;
        for (int t = 0; t < nt; t += 2) {
            const bool last = (t == nt - 2);
            const char* a1 = cA + (size_t)(t + 1) * kstep;
            const char* a2 = last ? nA : cA + (size_t)(t + 2) * kstep; const char* b2 = last ? nB : cB + (size_t)(t + 2) * kstep;
            const char* a3 = a2 + kstep; const char* b3 = b2 + kstep;
            if (last && has_next) S.a_ready(nxt);
            if constexpr (SP2) {
            PG8_LDB(B0, 0, 0); PG8_LDB(B1, 0, 1); PG8_SCHED; PG8_LDA(At, 0, 0); PG8_STAGE(PG8_SA(1, 1), a1 + hstep, voffA);
            PG8_WAIT_V(8); PG8_WAIT_L(0); PG8_BAR; PG8_MMA(0, 0, At, B0); PG8_MMA(0, 1, At, B1); PG8_BAR; PG8_SCHED;
            PG8_LDA(At, 0, 1); PG8_STAGE(PG8_SB(0, 0), b2, voffB); PG8_STAGE(PG8_SB(0, 1), b2 + hstep, voffB); PG8_STAGE(PG8_SA(0, 0), a2, voffA);
            PG8_WAIT_V(8); PG8_WAIT_L(0); PG8_BAR; PG8_MMA(1, 0, At, B0); PG8_MMA(1, 1, At, B1); PG8_BAR; PG8_SCHED;
            PG8_LDB(B0, 1, 0); PG8_LDB(B1, 1, 1); PG8_SCHED; PG8_LDA(At, 1, 0); PG8_STAGE(PG8_SA(0, 1), a2 + hstep, voffA);
            PG8_WAIT_V(8); PG8_WAIT_L(0); PG8_BAR; PG8_MMA(0, 0, At, B0); PG8_MMA(0, 1, At, B1); PG8_BAR; PG8_SCHED;
            PG8_LDA(At, 1, 1); PG8_STAGE(PG8_SB(1, 0), b3, voffB); PG8_STAGE(PG8_SB(1, 1), b3 + hstep, voffB); PG8_STAGE(PG8_SA(1, 0), a3, voffA);
            PG8_WAIT_V(8); PG8_WAIT_L(0); PG8_BAR; PG8_MMA(1, 0, At, B0); PG8_MMA(1, 1, At, B1); PG8_BAR; PG8_SCHED;
            } else {
            PG8_LDB(B0, 0, 0); PG8_SCHED; PG8_LDA(At, 0, 0); PG8_STAGE(PG8_SA(1, 1), a1 + hstep, voffA);
            PG8_WAIT_L(8); PG8_BAR; PG8_WAIT_L(0); PG8_MMA(0, 0, At, B0); PG8_BAR; PG8_SCHED;
            PG8_LDB(B1, 0, 1); PG8_STAGE(PG8_SB(0, 0), b2, voffB);
            PG8_BAR; PG8_WAIT_L(0); PG8_MMA(0, 1, At, B1); PG8_BAR;
            PG8_LDA(At, 0, 1); PG8_STAGE(PG8_SA(0, 0), a2, voffA);
            PG8_BAR; PG8_WAIT_L(0); PG8_MMA(1, 0, At, B0); PG8_BAR; PG8_SCHED;
            PG8_STAGE(PG8_SB(0, 1), b2 + hstep, voffB);
            PG8_WAIT_V(6); PG8_BAR; PG8_MMA(1, 1, At, B1); PG8_BAR;
            PG8_LDB(B0, 1, 0); PG8_SCHED; PG8_LDA(At, 1, 0); PG8_STAGE(PG8_SA(0, 1), a2 + hstep, voffA);
            PG8_WAIT_L(8); PG8_BAR; PG8_WAIT_L(0); PG8_MMA(0, 0, At, B0); PG8_BAR; PG8_SCHED;
            PG8_LDB(B1, 1, 1); PG8_STAGE(PG8_SB(1, 0), b3, voffB);
            PG8_BAR; PG8_WAIT_L(0); PG8_MMA(0, 1, At, B1); PG8_BAR;
            PG8_LDA(At, 1, 1); PG8_STAGE(PG8_SA(1, 0), a3, voffA);
            PG8_BAR; PG8_WAIT_L(0); PG8_MMA(1, 0, At, B0); PG8_BAR; PG8_SCHED;
            PG8_STAGE(PG8_SB(1, 1), b3 + hstep, voffB);
            PG8_WAIT_V(6); PG8_BAR; PG8_MMA(1, 1, At, B1); PG8_BAR;
            }
        }
        if constexpr (ALIGN_EPI) { if (wr == 0) PG8_BAR; }
        if constexpr (!Epi::AFTER_DRAIN) { E(acc, cur, wr, wc, fr, fq); S.done(cur); }
        if (!has_next) break;
#pragma unroll
        for (int a = 0; a < 2; ++a)
#pragma unroll
            for (int b = 0; b < 2; ++b)
#pragma unroll
                for (int m = 0; m < 4; ++m)
#pragma unroll
                    for (int n = 0; n < 2; ++n) acc[a][b][m][n] = (f32x4){0.f, 0.f, 0.f, 0.f};
        cur = nxt; cA = nA; cB = nB; ++ui;
        if constexpr (ALIGN_EPI) { if (wr == 1) PG8_BAR; }
    }
    PG8_WAIT_V(0);
    if constexpr (!ALIGN_EPI) { if (wr == 0) PG8_BAR; }
    PG8_BAR;
    if constexpr (Epi::AFTER_DRAIN) { E.fused(acc, cur, wr, wc, fr, fq, lds, wid, lane); S.done(cur); }
#undef PG8_SA
#undef PG8_SB
#undef PG8_STAGE
#undef PG8_LDA
#undef PG8_LDB
#undef PG8_MMA
#undef PG8_WAIT_V
#undef PG8_WAIT_L
#undef PG8_BAR
#undef PG8_SCHED
}
}
#define LAS __attribute__((address_space(3)))
typedef unsigned short bf16_t;
typedef short bf16x8 __attribute__((ext_vector_type(8)));
typedef short s16x4 __attribute__((ext_vector_type(4)));
typedef float f32x4 __attribute__((ext_vector_type(4)));
typedef float f32x16 __attribute__((ext_vector_type(16)));
typedef unsigned u32x4 __attribute__((ext_vector_type(4)));
typedef unsigned u32x2 __attribute__((ext_vector_type(2)));

constexpr int NB = 8, SEQ = 2048, DM = 2048, MROWS = NB * SEQ;
constexpr int DIN = 7728, NP = 7936;
constexpr int QA_OFF = 0, KCMP_OFF = 1024, VCMP_OFF = 1280, KSLC_OFF = 1536, VSLC_OFF = 1792, KWIN_OFF = 2048, VWIN_OFF = 2304;
constexpr int ZA_OFF = 2560, QH_OFF = 3584, FH_OFF = 4608, IH_OFF = 5632, ZH_OFF = 6656, GATE_OFF = 7680;
constexpr int NCMP = 127;
constexpr float EPSN = 1e-6f;
constexpr float LOG2E = 1.4426950408889634f;
constexpr float QSCALE = 0.125f * LOG2E;
constexpr int NWAVES = 8, NTHREADS = 512;
constexpr int LDS_BYTES = 147456;
constexpr int LDS_CTL = 147456 - 256;

constexpr size_t MiB = 1u << 20;
constexpr size_t WS_CTL = 0;
constexpr size_t WS_W1T = 1 * MiB;
constexpr size_t WS_WOT = 32 * MiB;
constexpr size_t WS_CW1T = 40 * MiB;
constexpr size_t WS_CW2T = 42 * MiB;
constexpr size_t WS_BPE = 42 * MiB + 65536;
constexpr size_t WS_KVC = 43 * MiB;
constexpr size_t WS_RSP = 44 * MiB;
constexpr size_t WS_HB = 48 * MiB;
constexpr size_t WS_MIX = 112 * MiB;
constexpr size_t WS_PROJ = 176 * MiB;
constexpr size_t WS_END = 424 * MiB;

struct Params {
    const float* x; const float* norm_in; const float* w_in; const float* pe_k; const float* w1_k; const float* w2_k;
    const float* pe_v; const float* w1_v; const float* w2_v; const float* lower_bounds; const float* nsa_norm; const float* hgrn_norm;
    const float* w_out; const float* final_norm; float* out; unsigned char* ws; int ph_lo, ph_hi;
};

__device__ __forceinline__ float bf2f(unsigned short h) { return __uint_as_float((unsigned)h << 16); }
__device__ __forceinline__ unsigned cvtpk(float lo, float hi) { return pg8::cvt_pk_bf16(lo, hi); }
__device__ __forceinline__ unsigned short f2bf1(float v) { return (unsigned short)(cvtpk(v, 0.f) & 0xffffu); }
__device__ __forceinline__ float ex2(float v) { return __builtin_amdgcn_exp2f(v); }
__device__ __forceinline__ float lg2(float v) { return __builtin_amdgcn_logf(v); }
__device__ __forceinline__ float rcp(float v) { return __builtin_amdgcn_rcpf(v); }
__device__ __forceinline__ float sigmoidf_(float v) { return rcp(1.f + ex2(-v * LOG2E)); }
__device__ __forceinline__ float siluf_(float v) { return v * sigmoidf_(v); }
__device__ __forceinline__ float wave_sum(float v) {
#pragma unroll
    for (int o = 1; o < 64; o <<= 1) v += __shfl_xor(v, o);
    return v;
}
#define LDS_WAIT() asm volatile("s_waitcnt lgkmcnt(0)" ::: "memory")

struct MapId { __device__ __forceinline__ int operator()(int c) const { return c; } };
struct MapWin { __device__ __forceinline__ int operator()(int c) const { return c < 2560 ? c : (c < 7680 ? c + 48 : (c < 7728 ? c - 7680 + 2560 : -1)); } };
template <class MapF>
__device__ __forceinline__ void p0_transpose_item(const float* W, int K, int Nsrc, bf16_t* WT, LAS float* scr, int item, int nblk, int lane, MapF map) {
    const int kb = item / nblk, nb = item % nblk, k0 = 64 * kb, n0 = 32 * nb;
    const int sc = map(n0 + (lane & 31));
#pragma unroll 8
    for (int i = 0; i < 32; ++i) { const int kk = 2 * i + (lane >> 5); scr[kk * 33 + (lane & 31)] = sc >= 0 ? W[(size_t)(k0 + kk) * Nsrc + sc] : 0.f; }
    LDS_WAIT(); asm volatile("" ::: "memory");
    const int c = lane & 7;
#pragma unroll
    for (int j = 0; j < 4; ++j) { const int n = (lane >> 3) + 8 * j; const LAS float* s = scr + (8 * c) * 33 + n;
        u32x4 o; o.x = cvtpk(s[0 * 33], s[1 * 33]); o.y = cvtpk(s[2 * 33], s[3 * 33]); o.z = cvtpk(s[4 * 33], s[5 * 33]); o.w = cvtpk(s[6 * 33], s[7 * 33]);
        *(u32x4*)(WT + (size_t)(n0 + n) * K + k0 + 8 * c) = o; }
    LDS_WAIT(); asm volatile("" ::: "memory");
}
__device__ __forceinline__ void rms_row_to_bf16(const float* xrow, const float* g, bf16_t* orow, int lane) {
    const f32x4* xr = (const f32x4*)xrow + lane; const f32x4* gr = (const f32x4*)g + lane;
    f32x4 v[8]; float s = 0.f;
#pragma unroll
    for (int j = 0; j < 8; ++j) { v[j] = xr[64 * j]; s += (v[j].x * v[j].x + v[j].y * v[j].y) + (v[j].z * v[j].z + v[j].w * v[j].w); }
    const float rstd = __builtin_amdgcn_rsqf(wave_sum(s) * (1.f / DM) + EPSN);
    u32x2* o8 = (u32x2*)orow + lane;
#pragma unroll
    for (int j = 0; j < 8; ++j) { const f32x4 gg = gr[64 * j]; u32x2 w; w.x = cvtpk(v[j].x * rstd * gg.x, v[j].y * rstd * gg.y); w.y = cvtpk(v[j].z * rstd * gg.z, v[j].w * rstd * gg.w); o8[64 * j] = w; }
}
__device__ __forceinline__ void phase0(const Params& P, LAS unsigned char* lds, int G) {
    const int tid = threadIdx.x, lane = tid & 63, wave = __builtin_amdgcn_readfirstlane(tid >> 6);
    unsigned char* ws = P.ws;
    bf16_t* W1T = (bf16_t*)(ws + WS_W1T); bf16_t* WOT = (bf16_t*)(ws + WS_WOT); bf16_t* CW1T = (bf16_t*)(ws + WS_CW1T); bf16_t* CW2T = (bf16_t*)(ws + WS_CW2T);
    bf16_t* HB = (bf16_t*)(ws + WS_HB); float* BPE = (float*)(ws + WS_BPE);
    LAS float* scr = (LAS float*)(lds + wave * 16384);
    const int gw = blockIdx.x * NWAVES + wave, NGW = G * NWAVES;
    constexpr int I_IN = 32 * (NP / 32), I_OUT = 32 * (DM / 32), I_C1 = 32 * 8, I_C2 = 4 * 2;
    constexpr int NITEMS = I_IN + I_OUT + 2 * I_C1 + 2 * I_C2;
    for (int it = gw; it < NITEMS; it += NGW) {
        int r = it;
        if (r < I_IN) { p0_transpose_item(P.w_in, DM, DIN, W1T, scr, r, NP / 32, lane, MapWin()); continue; } r -= I_IN;
        if (r < I_OUT) { p0_transpose_item(P.w_out, DM, DM, WOT, scr, r, DM / 32, lane, MapId()); continue; } r -= I_OUT;
        if (r < I_C1) { p0_transpose_item(P.w1_k, 2048, 256, CW1T, scr, r, 8, lane, MapId()); continue; } r -= I_C1;
        if (r < I_C1) { p0_transpose_item(P.w1_v, 2048, 256, CW1T + 256 * 2048, scr, r, 8, lane, MapId()); continue; } r -= I_C1;
        if (r < I_C2) { p0_transpose_item(P.w2_k, 256, 64, CW2T, scr, r, 2, lane, MapId()); continue; } r -= I_C2;
        p0_transpose_item(P.w2_v, 256, 64, CW2T + 64 * 256, scr, r, 2, lane, MapId());
    }
    for (int m = gw; m < MROWS; m += NGW) rms_row_to_bf16(P.x + (size_t)m * DM, P.norm_in, HB + (size_t)m * DM, lane);
    __syncthreads();
    for (int u = blockIdx.x; u < 32; u += G) {
        const int kv = u >> 4, part = u & 15; const float* pe = kv ? P.pe_v : P.pe_k; const float* w1 = kv ? P.w1_v : P.w1_k;
        const int n = tid & 255, kh = tid >> 8; float s = 0.f;
#pragma unroll 8
        for (int i = 0; i < 64; ++i) { const int k = part * 128 + kh * 64 + i; s += pe[k] * w1[(size_t)k * 256 + n]; }
        LAS float* red = (LAS float*)lds;
        __syncthreads();
        if (kh) red[n] = s;
        __syncthreads();
        if (!kh) BPE[(kv * 16 + part) * 256 + n] = s + red[n];
        __syncthreads();
    }
}

__device__ __forceinline__ float gelu_tanh(float v) {
    const float u = 0.7978845608028654f * (v + 0.044715f * v * v * v);
    const float e = ex2(u * (2.f * LOG2E));
    const float th = 1.f - 2.f * rcp(1.f + e);
    return 0.5f * v * (1.f + th);
}
__device__ __forceinline__ void phase2(const Params& P, LAS unsigned char* lds, int G) {
    const int tid = threadIdx.x, lane = tid & 63, wave = __builtin_amdgcn_readfirstlane(tid >> 6), fr = lane & 15, fq = lane >> 4;
    unsigned char* ws = P.ws;
    const bf16_t* PROJ = (const bf16_t*)(ws + WS_PROJ); const bf16_t* CW1T = (const bf16_t*)(ws + WS_CW1T); const bf16_t* CW2T = (const bf16_t*)(ws + WS_CW2T);
    const float* BPE = (const float*)(ws + WS_BPE); bf16_t* KVC = (bf16_t*)(ws + WS_KVC);
    constexpr int XB = 0, HBO = 528 * 128;
    for (int u = blockIdx.x; u < 256; u += G) {
        const int kv = u >> 7, rem = u & 127, b = rem >> 4, g = (rem >> 2) & 3, n0 = 32 * (rem & 3);
        const bf16_t* src = PROJ + (size_t)b * SEQ * NP + (kv ? VCMP_OFF : KCMP_OFF) + g * 64;
        __syncthreads();
        for (int p = tid; p < 528 * 8; p += NTHREADS) { const int tok = p >> 3, c = p & 7; int t = 16 * n0 + tok; t = t < SEQ ? t : SEQ - 1;
            const u32x4 v = *(const u32x4*)(src + (size_t)t * NP + c * 8);
            *(LAS u32x4*)(lds + XB + tok * 128 + ((c ^ ((tok >> 4) & 7)) * 16)) = v; }
        __syncthreads();
        const bf16_t* w1t = CW1T + (size_t)kv * 256 * 2048;
        f32x4 acc[2][2];
#pragma unroll
        for (int a = 0; a < 2; ++a)
#pragma unroll
            for (int c = 0; c < 2; ++c) acc[a][c] = (f32x4){0.f, 0.f, 0.f, 0.f};
        const bf16_t* bp0 = w1t + (size_t)(32 * wave + fr) * 2048 + 8 * fq;
        const bf16_t* bp1 = bp0 + 16 * 2048;
#pragma unroll 4
        for (int ks = 0; ks < 64; ++ks) {
            const int l = ks >> 1, c = (ks & 1) * 4 + fq;
            const bf16x8 b0 = *(const bf16x8*)(bp0 + ks * 32), b1 = *(const bf16x8*)(bp1 + ks * 32);
            const int tok0 = 16 * fr + l, tok1 = 16 * (16 + fr) + l;
            const bf16x8 a0 = *(const LAS bf16x8*)(lds + XB + tok0 * 128 + ((c ^ ((tok0 >> 4) & 7)) * 16));
            const bf16x8 a1 = *(const LAS bf16x8*)(lds + XB + tok1 * 128 + ((c ^ ((tok1 >> 4) & 7)) * 16));
            acc[0][0] = __builtin_amdgcn_mfma_f32_16x16x32_bf16(a0, b0, acc[0][0], 0, 0, 0);
            acc[0][1] = __builtin_amdgcn_mfma_f32_16x16x32_bf16(a0, b1, acc[0][1], 0, 0, 0);
            acc[1][0] = __builtin_amdgcn_mfma_f32_16x16x32_bf16(a1, b0, acc[1][0], 0, 0, 0);
            acc[1][1] = __builtin_amdgcn_mfma_f32_16x16x32_bf16(a1, b1, acc[1][1], 0, 0, 0);
        }
#pragma unroll
        for (int nb = 0; nb < 2; ++nb) { const int hid = 32 * wave + 16 * nb + fr; float bias = 0.f;
#pragma unroll
            for (int p = 0; p < 16; ++p) bias += BPE[(kv * 16 + p) * 256 + hid];
#pragma unroll
            for (int mb = 0; mb < 2; ++mb)
#pragma unroll
                for (int r = 0; r < 4; ++r) { const int nl = 16 * mb + 4 * fq + r; *(LAS unsigned short*)(lds + HBO + nl * 528 + hid * 2) = f2bf1(gelu_tanh(acc[mb][nb][r] + bias)); } }
        __syncthreads();
        const bf16_t* w2t = CW2T + (size_t)kv * 64 * 256; const int mb = wave >> 2, nb = wave & 3;
        f32x4 o = (f32x4){0.f, 0.f, 0.f, 0.f};
#pragma unroll
        for (int ks = 0; ks < 8; ++ks) {
            const bf16x8 a = *(const LAS bf16x8*)(lds + HBO + (16 * mb + fr) * 528 + (32 * ks + 8 * fq) * 2);
            const bf16x8 bb = *(const bf16x8*)(w2t + (size_t)(16 * nb + fr) * 256 + 32 * ks + 8 * fq);
            o = __builtin_amdgcn_mfma_f32_16x16x32_bf16(a, bb, o, 0, 0, 0);
        }
        bf16_t* dst = KVC + ((size_t)((kv * NB + b) * 4 + g) * 128) * 64;
#pragma unroll
        for (int r = 0; r < 4; ++r) { const int n = n0 + 16 * mb + 4 * fq + r; dst[(size_t)n * 64 + 16 * nb + fr] = (n < NCMP) ? f2bf1(o[r]) : (unsigned short)0; }
    }
}
namespace hg {
constexpr int RS = 272;
constexpr int TS = 144;
constexpr int OS = 528;
constexpr int QS = 0, QE = QS + 64 * RS, KE = QE + 64 * RS, KLT = KE + 64 * RS, VT = KLT + 128 * TS, PP = VT + 128 * TS, OST = PP + 64 * TS, TOT = OST + 64 * OS, DEC = TOT + 4 * 128 * 4, END = DEC + 128 * 4;
static_assert(END <= LDS_CTL, "hgrn LDS map");
}
__device__ __forceinline__ void hgrn_unit(const Params& P, LAS unsigned char* lds, int unit) {
    using namespace hg;
    int tid_ = threadIdx.x; asm volatile("" : "+v"(tid_));
    const int tid = tid_, lane = tid & 63, wave = __builtin_amdgcn_readfirstlane(tid >> 6), fr = lane & 15, fq = lane >> 4;
    const int b = unit >> 3, h = unit & 7;
    unsigned char* ws = P.ws;
    const bf16_t* PROJ = (const bf16_t*)(ws + WS_PROJ); bf16_t* MIX = (bf16_t*)(ws + WS_MIX);
    const int d = tid & 127, sg = tid >> 7;
    float lb; { const float a = P.lower_bounds[h * 128 + d], bb = P.lower_bounds[1024 + h * 128 + d]; lb = rcp(1.f + ex2((bb - a) * LOG2E)); }
    f32x4 S[8];
#pragma unroll
    for (int i = 0; i < 8; ++i) S[i] = (f32x4){0.f, 0.f, 0.f, 0.f};
    const int et = tid >> 3, ec = tid & 7;
    f32x4 gain[4];
#pragma unroll
    for (int i = 0; i < 4; ++i) gain[i] = *(const f32x4*)(P.hgrn_norm + h * 128 + 16 * ec + 4 * i);
    for (int c = 0; c < 32; ++c) {
        const size_t row0 = (size_t)b * SEQ + c * 64;
        {
            const bf16_t* src = PROJ + (row0 + 16 * sg) * NP + h * 128 + d;
            unsigned short qraw[16], fraw[16], vraw[16];
#pragma unroll
            for (int i = 0; i < 16; ++i) { qraw[i] = src[(size_t)i * NP + QH_OFF]; fraw[i] = src[(size_t)i * NP + FH_OFF]; vraw[i] = src[(size_t)i * NP + IH_OFF]; }
            float kk[16], bl[16]; float run = 0.f;
#pragma unroll
            for (int i = 0; i < 16; ++i) { const float f = lb + (1.f - lb) * sigmoidf_(bf2f(fraw[i])); kk[i] = 1.f - f; run += lg2(f); bl[i] = run; }
            *(LAS float*)(lds + TOT + (sg * 128 + d) * 4) = run;
            __syncthreads();
            const float t0 = *(LAS float*)(lds + TOT + (0 * 128 + d) * 4), t1 = *(LAS float*)(lds + TOT + (1 * 128 + d) * 4), t2 = *(LAS float*)(lds + TOT + (2 * 128 + d) * 4), t3 = *(LAS float*)(lds + TOT + (3 * 128 + d) * 4);
            const float off = (sg > 0 ? t0 : 0.f) + (sg > 1 ? t1 : 0.f) + (sg > 2 ? t2 : 0.f);
            const float bmid = t0 + t1, ball = (t0 + t1) + (t2 + t3);
            unsigned klp[8], vp[8];
#pragma unroll
            for (int i = 0; i < 16; i += 2) {
                float klv[2];
#pragma unroll
                for (int j = 0; j < 2; ++j) { const int s = 16 * sg + i + j; const float bb = off + bl[i + j]; const float q = bf2f(qraw[i + j]);
                    *(LAS unsigned short*)(lds + QS + s * RS + d * 2) = f2bf1(q * ex2(bb));
                    *(LAS unsigned short*)(lds + QE + s * RS + d * 2) = f2bf1(q * ex2(bb - bmid));
                    *(LAS unsigned short*)(lds + KE + s * RS + d * 2) = f2bf1(kk[i + j] * ex2(bmid - bb));
                    klv[j] = kk[i + j] * ex2(ball - bb); }
                klp[i >> 1] = cvtpk(klv[0], klv[1]); vp[i >> 1] = (unsigned)vraw[i] | ((unsigned)vraw[i + 1] << 16);
            }
            *(LAS u32x4*)(lds + KLT + d * TS + sg * 32) = (u32x4){klp[0], klp[1], klp[2], klp[3]};
            *(LAS u32x4*)(lds + KLT + d * TS + sg * 32 + 16) = (u32x4){klp[4], klp[5], klp[6], klp[7]};
            *(LAS u32x4*)(lds + VT + d * TS + sg * 32) = (u32x4){vp[0], vp[1], vp[2], vp[3]};
            *(LAS u32x4*)(lds + VT + d * TS + sg * 32 + 16) = (u32x4){vp[4], vp[5], vp[6], vp[7]};
            if (sg == 0) *(LAS float*)(lds + DEC + d * 4) = ex2(ball);
        }
        __syncthreads();
        {
            const int tb = wave & 3, sh = wave >> 2;
#pragma unroll
            for (int sbi = 0; sbi < 2; ++sbi) { const int sb = 2 * sh + sbi;
                if (sb <= tb) {
                    f32x4 a = (f32x4){0.f, 0.f, 0.f, 0.f};
#pragma unroll
                    for (int st = 0; st < 4; ++st) {
                        const bf16x8 ka = *(const LAS bf16x8*)(lds + KE + (16 * sb + fr) * RS + (32 * st + 8 * fq) * 2);
                        const bf16x8 qb = *(const LAS bf16x8*)(lds + QE + (16 * tb + fr) * RS + (32 * st + 8 * fq) * 2);
                        a = __builtin_amdgcn_mfma_f32_16x16x32_bf16(ka, qb, a, 0, 0, 0);
                    }
                    const int t = 16 * tb + fr, s0 = 16 * sb + 4 * fq;
                    const float v0 = (s0 + 0 <= t) ? a[0] : 0.f, v1 = (s0 + 1 <= t) ? a[1] : 0.f, v2 = (s0 + 2 <= t) ? a[2] : 0.f, v3 = (s0 + 3 <= t) ? a[3] : 0.f;
                    *(LAS u32x2*)(lds + PP + t * TS + s0 * 2) = (u32x2){cvtpk(v0, v1), cvtpk(v2, v3)};
                } else if (2 * sh <= tb) {
                    const int t = 16 * tb + fr, s0 = 16 * sb + 4 * fq;
                    *(LAS u32x2*)(lds + PP + t * TS + s0 * 2) = (u32x2){0u, 0u};
                }
            }
        }
        __syncthreads();
        {
            bf16x8 vf[2];
#pragma unroll
            for (int i = 0; i < 2; ++i) vf[i] = *(const LAS bf16x8*)(lds + VT + (16 * wave + fr) * TS + (32 * i + 8 * fq) * 2);
            bf16x8 sb16[4];
#pragma unroll
            for (int st = 0; st < 4; ++st) { const unsigned w0 = cvtpk(S[2 * st][0], S[2 * st][1]), w1 = cvtpk(S[2 * st][2], S[2 * st][3]), w2 = cvtpk(S[2 * st + 1][0], S[2 * st + 1][1]), w3 = cvtpk(S[2 * st + 1][2], S[2 * st + 1][3]);
                sb16[st] = __builtin_bit_cast(bf16x8, (u32x4){w0, w1, w2, w3}); }
#pragma unroll
            for (int tb = 0; tb < 4; ++tb) {
                f32x4 o = (f32x4){0.f, 0.f, 0.f, 0.f};
#pragma unroll
                for (int st = 0; st < 4; ++st) {
                    const u32x2 lo = *(const LAS u32x2*)(lds + QS + (16 * tb + fr) * RS + (32 * st + 4 * fq) * 2);
                    const u32x2 hi = *(const LAS u32x2*)(lds + QS + (16 * tb + fr) * RS + (32 * st + 16 + 4 * fq) * 2);
                    const bf16x8 qa = __builtin_bit_cast(bf16x8, (u32x4){lo.x, lo.y, hi.x, hi.y});
                    o = __builtin_amdgcn_mfma_f32_16x16x32_bf16(qa, sb16[st], o, 0, 0, 0);
                }
#pragma unroll
                for (int i = 0; i < 2; ++i) if (2 * i <= tb) {
                    const bf16x8 pa = *(const LAS bf16x8*)(lds + PP + (16 * tb + fr) * TS + (32 * i + 8 * fq) * 2);
                    o = __builtin_amdgcn_mfma_f32_16x16x32_bf16(pa, vf[i], o, 0, 0, 0);
                }
#pragma unroll
                for (int r = 0; r < 4; ++r) *(LAS float*)(lds + OST + (16 * tb + 4 * fq + r) * OS + (16 * wave + fr) * 4) = o[r];
            }
#pragma unroll
            for (int db = 0; db < 8; ++db) {
                const f32x4 dc = *(const LAS f32x4*)(lds + DEC + (16 * db + 4 * fq) * 4);
                S[db] = S[db] * dc;
#pragma unroll
                for (int i = 0; i < 2; ++i) {
                    const bf16x8 ka = *(const LAS bf16x8*)(lds + KLT + (16 * db + fr) * TS + (32 * i + 8 * fq) * 2);
                    S[db] = __builtin_amdgcn_mfma_f32_16x16x32_bf16(ka, vf[i], S[db], 0, 0, 0);
                }
            }
        }
        __syncthreads();
        {
            f32x4 ov[4]; float ss = 0.f;
#pragma unroll
            for (int i = 0; i < 4; ++i) { ov[i] = *(const LAS f32x4*)(lds + OST + et * OS + (16 * ec + 4 * i) * 4); ss += (ov[i].x * ov[i].x + ov[i].y * ov[i].y) + (ov[i].z * ov[i].z + ov[i].w * ov[i].w); }
            ss += __shfl_xor(ss, 1); ss += __shfl_xor(ss, 2); ss += __shfl_xor(ss, 4);
            const float rstd = __builtin_amdgcn_rsqf(ss * (1.f / 128.f) + EPSN);
            const bf16_t* zp = PROJ + (row0 + et) * NP + ZH_OFF + h * 128 + 16 * ec;
            const u32x4 z0 = *(const u32x4*)zp, z1 = *(const u32x4*)(zp + 8);
            const unsigned zw[8] = {z0.x, z0.y, z0.z, z0.w, z1.x, z1.y, z1.z, z1.w};
            unsigned ow[8];
#pragma unroll
            for (int i = 0; i < 8; ++i) { const float za = __uint_as_float(zw[i] << 16), zb = __uint_as_float(zw[i] & 0xffff0000u);
                const float oa = ov[i >> 1][(2 * i) & 3] * rstd * gain[i >> 1][(2 * i) & 3] * siluf_(za);
                const float ob = ov[i >> 1][(2 * i + 1) & 3] * rstd * gain[i >> 1][(2 * i + 1) & 3] * siluf_(zb);
                ow[i] = cvtpk(oa, ob); }
            bf16_t* op = MIX + (row0 + et) * DM + 1024 + h * 128 + 16 * ec;
            *(u32x4*)op = (u32x4){ow[0], ow[1], ow[2], ow[3]}; *(u32x4*)(op + 8) = (u32x4){ow[4], ow[5], ow[6], ow[7]};
        }
    }
    __syncthreads();
}
namespace at {
constexpr int KB0 = 0, KB1 = 8192, VB0 = 16384, VB1 = 24576, PS4 = 32768, SELM = PS4 + 4 * 64 * 33 * 4, UNI = SELM + 256, TL = UNI + 64, TLN = TL + 64 * 4, OAC = TLN + 64, END = OAC + 8 * 8192;
static_assert(END <= LDS_CTL, "attention LDS map");
}
typedef short v4i16_t __attribute__((ext_vector_type(4)));
__device__ __forceinline__ s16x4 vtr(const LAS unsigned char* p) { return __builtin_bit_cast(s16x4, __builtin_amdgcn_ds_read_tr16_b64_v4i16((LAS v4i16_t*)p)); }
__device__ __forceinline__ float xhalf(float v) { return __shfl_xor(v, 32); }

__device__ __forceinline__ void kv_load(u32x4& kr, u32x4& vr, const bf16_t* kbase, const bf16_t* vbase, int pitch, int wave, int lane) {
    kr = *(const u32x4*)(kbase + (size_t)lane * pitch + wave * 8);
    vr = *(const u32x4*)(vbase + (size_t)(16 * (wave & 3) + (lane >> 2)) * pitch + (wave >> 2) * 32 + (lane & 3) * 8);
}
__device__ __forceinline__ void kv_store(const u32x4& kr, const u32x4& vr, LAS unsigned char* kslot, LAS unsigned char* vslot, int wave, int lane) {
    *(LAS u32x4*)(kslot + wave * 1024 + lane * 16) = kr;
    *(LAS u32x4*)(vslot + wave * 1024 + lane * 16) = vr;
}
__device__ __forceinline__ void qkt(f32x16& p0, f32x16& p1, const LAS unsigned char* kslot, const bf16x8 (&qr)[4], int r32, int hi) {
    const LAS unsigned char* kb = kslot + hi * 1024 + r32 * 16;
    p0 = (f32x16){0.f, 0.f, 0.f, 0.f, 0.f, 0.f, 0.f, 0.f, 0.f, 0.f, 0.f, 0.f, 0.f, 0.f, 0.f, 0.f}; p1 = p0;
#pragma unroll
    for (int d0 = 0; d0 < 4; ++d0) {
        const bf16x8 b0 = *(const LAS bf16x8*)(kb + d0 * 2048), b1 = *(const LAS bf16x8*)(kb + d0 * 2048 + 512);
        p0 = __builtin_amdgcn_mfma_f32_32x32x16_bf16(b0, qr[d0], p0, 0, 0, 0);
        p1 = __builtin_amdgcn_mfma_f32_32x32x16_bf16(b1, qr[d0], p1, 0, 0, 0);
    }
}
__device__ __forceinline__ void pv(f32x16 (&o)[2], const LAS unsigned char* vslot, const f32x16& p0, const f32x16& p1, int lane) {
    const int hi = lane >> 5;
    const LAS unsigned char* vb = vslot + ((lane >> 4) & 1) * 32 + (lane & 3) * 8 + (4 * hi + ((lane & 15) >> 2)) * 64;
    bf16x8 pb[4];
#pragma unroll
    for (int s = 0; s < 2; ++s) {
        pb[s] = __builtin_bit_cast(bf16x8, (u32x4){cvtpk(p0[8 * s + 0], p0[8 * s + 1]), cvtpk(p0[8 * s + 2], p0[8 * s + 3]), cvtpk(p0[8 * s + 4], p0[8 * s + 5]), cvtpk(p0[8 * s + 6], p0[8 * s + 7])});
        pb[2 + s] = __builtin_bit_cast(bf16x8, (u32x4){cvtpk(p1[8 * s + 0], p1[8 * s + 1]), cvtpk(p1[8 * s + 2], p1[8 * s + 3]), cvtpk(p1[8 * s + 4], p1[8 * s + 5]), cvtpk(p1[8 * s + 6], p1[8 * s + 7])});
    }
#pragma unroll
    for (int d0 = 0; d0 < 2; ++d0)
#pragma unroll
        for (int ks = 0; ks < 4; ++ks) {
            const s16x4 lo = vtr(vb + d0 * 4096 + ks * 1024), hh = vtr(vb + d0 * 4096 + ks * 1024 + 512);
            const bf16x8 vf = (bf16x8){lo[0], lo[1], lo[2], lo[3], hh[0], hh[1], hh[2], hh[3]};
            o[d0] = __builtin_amdgcn_mfma_f32_32x32x16_bf16(vf, pb[ks], o[d0], 0, 0, 0);
        }
}
__device__ __forceinline__ void tile_step(f32x16 (&o)[2], float& m, float& l, const LAS unsigned char* kslot, const LAS unsigned char* vslot, const bf16x8 (&qr)[4],
                                          float sl, float ub, bool boundary, int dl1, unsigned rng, int lane) {
    const int r32 = lane & 31, hi = lane >> 5;
    f32x16 p0, p1;
    qkt(p0, p1, kslot, qr, r32, hi);
    if (boundary) {
#pragma unroll
        for (int r = 0; r < 16; ++r) { const int c = (r & 3) + 8 * (r >> 2) + 4 * hi;
            p0[r] = ((unsigned)(c - dl1) <= rng) ? p0[r] : -INFINITY; p1[r] = ((unsigned)(c + 32 - dl1) <= rng) ? p1[r] : -INFINITY; }
    }
    const float sl4 = sl * (float)(4 * hi);
    float mx = -INFINITY;
#pragma unroll
    for (int r = 0; r < 16; ++r) { const float cf = (float)((r & 3) + 8 * (r >> 2));
        p0[r] = fmaf(sl, cf, p0[r]); p1[r] = fmaf(sl, cf + 32.f, p1[r]); mx = fmaxf(mx, fmaxf(p0[r], p1[r])); }
    const float ubl = ub + sl4;
    mx = mx + ubl; mx = fmaxf(mx, xhalf(mx));
    const float mn = fmaxf(m, mx), alpha = ex2(m - mn); m = mn;
    const float sub = mn - ubl;
    float sum = 0.f;
#pragma unroll
    for (int r = 0; r < 16; ++r) { p0[r] = ex2(p0[r] - sub); p1[r] = ex2(p1[r] - sub); sum += p0[r] + p1[r]; }
    l = l * alpha + sum;
#pragma unroll
    for (int r = 0; r < 16; ++r) { o[0][r] *= alpha; o[1][r] *= alpha; }
    pv(o, vslot, p0, p1, lane);
}

__device__ __forceinline__ void attn_unit(const Params& P, LAS unsigned char* lds, int unit) {
    using namespace at;
    int tid_ = threadIdx.x; asm volatile("" : "+v"(tid_));
    const int tid = tid_, lane = tid & 63, wave = __builtin_amdgcn_readfirstlane(tid >> 6), r32 = lane & 31, hi = lane >> 5;
    const int b = unit >> 7, g = (unit >> 5) & 3, qt = unit & 31, t0 = qt * 64;
    const int hr = wave >> 1, th = wave & 1, hq = 4 * g + hr;
    const int tq = t0 + 32 * th + r32;
    unsigned char* ws = P.ws;
    const bf16_t* PROJ = (const bf16_t*)(ws + WS_PROJ); bf16_t* MIX = (bf16_t*)(ws + WS_MIX); const bf16_t* KVC = (const bf16_t*)(ws + WS_KVC);
    const size_t brow = (size_t)b * SEQ;
    const float sl = ex2(-0.5f * (float)(hq + 1)) * LOG2E;
    const bf16_t* qp = PROJ + (brow + tq) * NP + QA_OFF + hq * 64;
    bf16x8 qr[4];
#pragma unroll
    for (int d0 = 0; d0 < 4; ++d0) qr[d0] = *(const bf16x8*)(qp + d0 * 16 + hi * 8);
    float gate[3];
#pragma unroll
    for (int i = 0; i < 3; ++i) gate[i] = sigmoidf_(bf2f(PROJ[(brow + tq) * NP + GATE_OFF + hq * 3 + i]));

#if defined(EXPORT_BR)
    float* OBX = (float*)(ws + 424 * MiB) + (brow + tq) * 1024 + hq * 64;
#define EXPORT_O(OO, SCL) do { _Pragma("unroll") for (int d0_ = 0; d0_ < 2; ++d0_) _Pragma("unroll") for (int r_ = 0; r_ < 16; ++r_) OBX[32 * d0_ + (r_ & 3) + 8 * (r_ >> 2) + 4 * hi] = OO[d0_][r_] * (SCL); } while (0)
#endif
    f32x16 oacc[2];
    __syncthreads();
    {
        const bf16_t* kc = KVC + ((size_t)((0 * NB + b) * 4 + g) * 128) * 64; const bf16_t* vc = KVC + ((size_t)((1 * NB + b) * 4 + g) * 128) * 64;
        u32x4 k0, v0, k1, v1;
        kv_load(k0, v0, kc, vc, 64, wave, lane); kv_load(k1, v1, kc + 64 * 64, vc + 64 * 64, 64, wave, lane);
        kv_store(k0, v0, lds + KB0, lds + VB0, wave, lane); kv_store(k1, v1, lds + KB1, lds + VB1, wave, lane);
        if (tid < 64) *(LAS unsigned*)(lds + SELM + tid * 4) = 0u;
        if (tid == 64) *(LAS unsigned*)(lds + UNI) = 0u;
    }
    __syncthreads();
    {
        f32x16 s[4];
        qkt(s[0], s[1], lds + KB0, qr, r32, hi); qkt(s[2], s[3], lds + KB1, qr, r32, hi);
        int nmax = (tq - 31) >> 4; nmax = nmax < (NCMP - 1) ? nmax : (NCMP - 1);
        const float sl16 = 16.f * sl; float mx = -INFINITY;
#pragma unroll
        for (int bi = 0; bi < 4; ++bi)
#pragma unroll
            for (int r = 0; r < 16; ++r) { const int n = 32 * bi + (r & 3) + 8 * (r >> 2) + 4 * hi;
                s[bi][r] = (n <= nmax) ? s[bi][r] + sl16 * (float)(n - 4 * qt) : -INFINITY; mx = fmaxf(mx, s[bi][r]); }
        mx = fmaxf(mx, xhalf(mx));
        const float mm = fmaxf(mx, -1e30f);
        float sum = 0.f;
#pragma unroll
        for (int bi = 0; bi < 4; ++bi)
#pragma unroll
            for (int r = 0; r < 16; ++r) { s[bi][r] = ex2(s[bi][r] - mm); sum += s[bi][r]; }
        sum += xhalf(sum);
        const float inv = sum > 0.f ? rcp(sum) : 0.f;
        float A[16], Bv[16];
#pragma unroll
        for (int bi = 0; bi < 4; ++bi)
#pragma unroll
            for (int i = 0; i < 4; ++i) { const float h3 = 0.5f * s[bi][4 * i + 3]; A[4 * bi + i] = ((s[bi][4 * i] + s[bi][4 * i + 1]) + s[bi][4 * i + 2]) + h3; Bv[4 * bi + i] = h3; }
        LAS float* ps = (LAS float*)(lds + PS4) + (hr * 64 + 32 * th + r32) * 33;
#pragma unroll
        for (int e = 0; e < 16; ++e) {
            const float other = xhalf(Bv[e]);
            const float otherprev = e > 0 ? xhalf(Bv[e - 1]) : 0.f;
            const float add = hi ? other : otherprev;
            ps[2 * e + hi] = (A[e] + add) * inv;
        }
        oacc[0] = (f32x16){0.f, 0.f, 0.f, 0.f, 0.f, 0.f, 0.f, 0.f, 0.f, 0.f, 0.f, 0.f, 0.f, 0.f, 0.f, 0.f}; oacc[1] = oacc[0];
        pv(oacc, lds + VB0, s[0], s[1], lane); pv(oacc, lds + VB1, s[2], s[3], lane);
#if defined(EXPORT_BR) && EXPORT_BR == 0
        EXPORT_O(oacc, inv);
#endif
        const float sc = inv * gate[0];
#pragma unroll
        for (int r = 0; r < 16; ++r) { *(LAS float*)(lds + OAC + wave * 8192 + r * 256 + lane * 4) = oacc[0][r] * sc; *(LAS float*)(lds + OAC + wave * 8192 + (16 + r) * 256 + lane * 4) = oacc[1][r] * sc; }
    }
    __syncthreads();
    {
        const int tok = tid & 63, jg = tid >> 6; const int t = t0 + tok, cur = t >> 6;
        const LAS float* p4 = (const LAS float*)(lds + PS4) + tok * 33;
        float sc[32];
#pragma unroll
        for (int j = 0; j < 32; ++j) { const float p = ((p4[j] + p4[64 * 33 + j]) + p4[2 * 64 * 33 + j]) + p4[3 * 64 * 33 + j];
            const bool forced = (j == 0) || (j == cur) || (j == cur - 1);
            sc[j] = (j > cur) ? -1.f : p + (forced ? 1.0e4f : 0.f); }
        unsigned bits = 0u;
#pragma unroll
        for (int jj = 0; jj < 4; ++jj) {
            float mine = 0.f;
#pragma unroll
            for (int j = 0; j < 32; ++j) mine = (j == 4 * jg + jj) ? sc[j] : mine;
            const int jme = 4 * jg + jj; int cnt = 0;
#pragma unroll
            for (int i = 0; i < 32; ++i) cnt += ((sc[i] > mine) || (sc[i] == mine && i < jme)) ? 1 : 0;
            if (cnt < 8 && jme <= cur) bits |= 1u << jme;
        }
        if (bits) { __hip_atomic_fetch_or((LAS unsigned*)(lds + SELM + tok * 4), bits, __ATOMIC_RELAXED, __HIP_MEMORY_SCOPE_WORKGROUP); __hip_atomic_fetch_or((LAS unsigned*)(lds + UNI), bits, __ATOMIC_RELAXED, __HIP_MEMORY_SCOPE_WORKGROUP); }
    }
    __syncthreads();
    if (tid == 0) {
        unsigned u = *(LAS unsigned*)(lds + UNI); int n = 0;
        while (u) { const int j = __builtin_ctz(u); u &= u - 1; *(LAS int*)(lds + TL + 4 * n) = j; ++n; }
        const int w0 = qt >= 8 ? qt - 8 : 0;
        for (int j = w0; j <= qt; ++j) { *(LAS int*)(lds + TL + 4 * n) = 64 + j; ++n; }
        *(LAS int*)(lds + TLN) = n;
    }
    __syncthreads();
    {
        const int ntile = __builtin_amdgcn_readfirstlane(*(LAS int*)(lds + TLN));
        const unsigned selmask = *(LAS unsigned*)(lds + SELM + (32 * th + r32) * 4);
#if defined(EXPORT_SEL)
        if (hr == 0 && hi == 0) ((unsigned*)(ws + 490 * MiB))[(b * 4 + g) * SEQ + tq] = selmask;
#endif
        const bf16_t* ks_base = PROJ + brow * NP + KSLC_OFF + g * 64; const bf16_t* vs_base = PROJ + brow * NP + VSLC_OFF + g * 64;
        const bf16_t* kw_base = PROJ + brow * NP + KWIN_OFF + g * 64; const bf16_t* vw_base = PROJ + brow * NP + VWIN_OFF + g * 64;
        f32x16 o[2]; o[0] = (f32x16){0.f, 0.f, 0.f, 0.f, 0.f, 0.f, 0.f, 0.f, 0.f, 0.f, 0.f, 0.f, 0.f, 0.f, 0.f, 0.f}; o[1] = o[0];
        float m = -1e30f, l = 0.f; int prev_win = 0;
        u32x4 kr, vr;
        { const int e = __builtin_amdgcn_readfirstlane(*(LAS int*)(lds + TL)); const int win = e >> 6, j = e & 63;
          kv_load(kr, vr, (win ? kw_base : ks_base) + (size_t)(64 * j) * NP, (win ? vw_base : vs_base) + (size_t)(64 * j) * NP, NP, wave, lane);
          kv_store(kr, vr, lds + KB0, lds + VB0, wave, lane); }
        __syncthreads();
        for (int i = 0; i < ntile; ++i) {
            const int e = __builtin_amdgcn_readfirstlane(*(LAS int*)(lds + TL + 4 * i)); const int win = e >> 6, j = e & 63;
            if (i + 1 < ntile) { const int e2 = __builtin_amdgcn_readfirstlane(*(LAS int*)(lds + TL + 4 * (i + 1))); const int win2 = e2 >> 6, j2 = e2 & 63;
                kv_load(kr, vr, (win2 ? kw_base : ks_base) + (size_t)(64 * j2) * NP, (win2 ? vw_base : vs_base) + (size_t)(64 * j2) * NP, NP, wave, lane); }
            if (win != prev_win) {
                const float lt = l + xhalf(l); const float sc = (lt > 0.f ? rcp(lt) : 0.f) * gate[1];
#if defined(EXPORT_BR) && EXPORT_BR == 1
                EXPORT_O(o, (lt > 0.f ? rcp(lt) : 0.f));
#endif
#pragma unroll
                for (int r = 0; r < 16; ++r) { LAS float* a0 = (LAS float*)(lds + OAC + wave * 8192 + r * 256 + lane * 4); LAS float* a1 = (LAS float*)(lds + OAC + wave * 8192 + (16 + r) * 256 + lane * 4);
                    *a0 = *a0 + o[0][r] * sc; *a1 = *a1 + o[1][r] * sc; o[0][r] = 0.f; o[1][r] = 0.f; }
                m = -1e30f; l = 0.f; prev_win = win;
            }
            const bool flag = win ? true : (((selmask >> j) & 1u) != 0u);
            const int kpos0 = 64 * j;
            const float ub = flag ? sl * (float)(kpos0 - t0) : -INFINITY;
            const bool boundary = win ? (j == qt || j + 8 == qt) : (j == qt);
            const int lo = win ? tq - 512 : -1;
            const int dl1 = lo + 1 - kpos0; const unsigned rng = (unsigned)(tq - lo - 1);
            const LAS unsigned char* ksl = lds + KB0 + (i & 1) * 8192; const LAS unsigned char* vsl = lds + VB0 + (i & 1) * 8192;
            tile_step(o, m, l, ksl, vsl, qr, sl, ub, boundary, dl1, rng, lane);
            if (i + 1 < ntile) kv_store(kr, vr, lds + KB0 + ((i + 1) & 1) * 8192, lds + VB0 + ((i + 1) & 1) * 8192, wave, lane);
            __syncthreads();
        }
        { const float lt = l + xhalf(l); const float sc = (lt > 0.f ? rcp(lt) : 0.f) * gate[2];
#if defined(EXPORT_BR) && EXPORT_BR == 2
          EXPORT_O(o, (lt > 0.f ? rcp(lt) : 0.f));
#endif
#pragma unroll
          for (int r = 0; r < 16; ++r) { oacc[0][r] = *(LAS float*)(lds + OAC + wave * 8192 + r * 256 + lane * 4) + o[0][r] * sc; oacc[1][r] = *(LAS float*)(lds + OAC + wave * 8192 + (16 + r) * 256 + lane * 4) + o[1][r] * sc; } }
    }
    {
        float ss = 0.f;
#pragma unroll
        for (int r = 0; r < 16; ++r) ss += oacc[0][r] * oacc[0][r] + oacc[1][r] * oacc[1][r];
        ss += xhalf(ss);
        const float rstd = __builtin_amdgcn_rsqf(ss * (1.f / 64.f) + EPSN);
        const bf16_t* zp = PROJ + (brow + tq) * NP + ZA_OFF + hq * 64; bf16_t* op = MIX + (brow + tq) * DM + hq * 64; const float* gp = P.nsa_norm + hq * 64;
#pragma unroll
        for (int d0 = 0; d0 < 2; ++d0)
#pragma unroll
            for (int q4 = 0; q4 < 4; ++q4) { const int dd = 32 * d0 + 8 * q4 + 4 * hi;
                const u32x2 z = *(const u32x2*)(zp + dd); const f32x4 gg = *(const f32x4*)(gp + dd);
                const float z0 = __uint_as_float(z.x << 16), z1 = __uint_as_float(z.x & 0xffff0000u), z2 = __uint_as_float(z.y << 16), z3 = __uint_as_float(z.y & 0xffff0000u);
                const float y0 = oacc[d0][4 * q4 + 0] * rstd * gg.x * siluf_(z0), y1 = oacc[d0][4 * q4 + 1] * rstd * gg.y * siluf_(z1);
                const float y2 = oacc[d0][4 * q4 + 2] * rstd * gg.z * siluf_(z2), y3 = oacc[d0][4 * q4 + 3] * rstd * gg.w * siluf_(z3);
                *(u32x2*)(op + dd) = (u32x2){cvtpk(y0, y1), cvtpk(y2, y3)}; }
    }
}
#if defined(NAIVE_HGRN)
__device__ __forceinline__ void hgrn_unit_naive(const Params& P, LAS unsigned char* lds, int unit) {
    int tid_ = threadIdx.x; asm volatile("" : "+v"(tid_)); const int tid = tid_; const int b = unit >> 3, h = unit & 7;
    const bf16_t* PROJ = (const bf16_t*)(P.ws + WS_PROJ); bf16_t* MIX = (bf16_t*)(P.ws + WS_MIX);
    LAS float* S = (LAS float*)lds;
    LAS float* QV = S + 128 * 129; LAS float* FV = QV + 128; LAS float* KV = FV + 128; LAS float* VV = KV + 128; LAS float* PART = VV + 128; LAS float* RED = PART + 512;
    const int e = tid & 127, dq = tid >> 7;
    for (int i = tid; i < 128 * 129; i += NTHREADS) S[i] = 0.f;
    float lb = 0.f; if (tid < 128) { const float a = P.lower_bounds[h * 128 + tid], bb = P.lower_bounds[1024 + h * 128 + tid]; lb = 1.f / (1.f + expf(bb - a)); }
    __syncthreads();
    for (int t = 0; t < SEQ; ++t) {
        const size_t row = (size_t)b * SEQ + t;
        if (tid < 128) { const bf16_t* src = PROJ + row * NP + h * 128 + tid; const float q = bf2f(src[QH_OFF]), fp = bf2f(src[FH_OFF]), v = bf2f(src[IH_OFF]);
            const float f = lb + (1.f - lb) * (1.f / (1.f + expf(-fp))); QV[tid] = q; FV[tid] = f; KV[tid] = 1.f - f; VV[tid] = v; }
        __syncthreads();
        float part = 0.f; const float ve = VV[e];
        for (int d = dq * 32; d < dq * 32 + 32; ++d) { const float s = FV[d] * S[d * 129 + e] + KV[d] * ve; S[d * 129 + e] = s; part += QV[d] * s; }
        PART[dq * 128 + e] = part;
        __syncthreads();
        if (tid < 128) { const float o = (PART[tid] + PART[128 + tid]) + (PART[256 + tid] + PART[384 + tid]);
            float ss = o * o; ss = wave_sum(ss); if ((tid & 63) == 0) RED[tid >> 6] = ss; }
        __syncthreads();
        if (tid < 128) { const float o = (PART[tid] + PART[128 + tid]) + (PART[256 + tid] + PART[384 + tid]); const float ss = RED[0] + RED[1];
            const float rstd = 1.f / sqrtf(ss / 128.f + EPSN); const float z = bf2f(PROJ[row * NP + ZH_OFF + h * 128 + tid]);
            MIX[row * DM + 1024 + h * 128 + tid] = f2bf1(o * rstd * P.hgrn_norm[h * 128 + tid] * (z / (1.f + expf(-z)))); }
    }
    __syncthreads();
}
#endif
#if defined(NAIVE_CMP)
__device__ __forceinline__ void phase2_naive(const Params& P, LAS unsigned char* lds, int G) {
    int tid_ = threadIdx.x; asm volatile("" : "+v"(tid_)); const int tid = tid_; const bf16_t* PROJ = (const bf16_t*)(P.ws + WS_PROJ); bf16_t* KVC = (bf16_t*)(P.ws + WS_KVC);
    LAS float* X = (LAS float*)lds; LAS float* Hd = X + 2048; LAS float* PR = Hd + 256;
    for (int u = blockIdx.x; u < 2 * NB * 4 * 128; u += G) {
        const int kv = u >> 12, b = (u >> 9) & 7, g = (u >> 7) & 3, n = u & 127;
        bf16_t* dst = KVC + ((size_t)((kv * NB + b) * 4 + g) * 128 + n) * 64;
        __syncthreads();
        if (n >= NCMP) { if (tid < 64) dst[tid] = 0; continue; }
        const float* pe = kv ? P.pe_v : P.pe_k; const float* w1 = kv ? P.w1_v : P.w1_k; const float* w2 = kv ? P.w2_v : P.w2_k;
        for (int k = tid; k < 2048; k += NTHREADS) { const int l = k >> 6, d = k & 63; X[k] = bf2f(PROJ[((size_t)b * SEQ + 16 * n + l) * NP + (kv ? VCMP_OFF : KCMP_OFF) + g * 64 + d]) + pe[k]; }
        __syncthreads();
        { const int hid = tid & 255, kh = tid >> 8; float s = 0.f; for (int k = kh * 1024; k < kh * 1024 + 1024; ++k) s += X[k] * w1[(size_t)k * 256 + hid]; PR[kh * 256 + hid] = s; }
        __syncthreads();
        if (tid < 256) { const float v = PR[tid] + PR[256 + tid]; const float uu = 0.7978845608028654f * (v + 0.044715f * v * v * v); Hd[tid] = 0.5f * v * (1.f + tanhf(uu)); }
        __syncthreads();
        if (tid < 64) { float s = 0.f; for (int k = 0; k < 256; ++k) s += Hd[k] * w2[k * 64 + tid]; dst[tid] = f2bf1(s); }
    }
}
#endif
#if defined(NAIVE_ATTN) || defined(EXPORT_SEL) || defined(EXPORT_BR)
__device__ __forceinline__ float dot64(const LAS float* q, const bf16_t* k) {
    float s = 0.f;
#pragma unroll
    for (int c = 0; c < 8; ++c) { const u32x4 w = *(const u32x4*)(k + 8 * c); const unsigned ww[4] = {w.x, w.y, w.z, w.w};
#pragma unroll
        for (int i = 0; i < 4; ++i) { s += q[(8 * c + 2 * i) * 256] * __uint_as_float(ww[i] << 16); s += q[(8 * c + 2 * i + 1) * 256] * __uint_as_float(ww[i] & 0xffff0000u); } }
    return s;
}
__device__ __forceinline__ void axpy64(float (&o)[64], float p, const bf16_t* v) {
#pragma unroll
    for (int c = 0; c < 8; ++c) { const u32x4 w = *(const u32x4*)(v + 8 * c); const unsigned ww[4] = {w.x, w.y, w.z, w.w};
#pragma unroll
        for (int i = 0; i < 4; ++i) { o[8 * c + 2 * i] += p * __uint_as_float(ww[i] << 16); o[8 * c + 2 * i + 1] += p * __uint_as_float(ww[i] & 0xffff0000u); } }
}
__device__ __forceinline__ void attn_unit_naive(const Params& P, LAS unsigned char* lds, int unit) {
    int tid_ = threadIdx.x; asm volatile("" : "+v"(tid_)); const int tid = tid_;
    const int b = unit >> 7, g = (unit >> 5) & 3, qt = unit & 31, t0 = qt * 64;
    const bf16_t* PROJ = (const bf16_t*)(P.ws + WS_PROJ); bf16_t* MIX = (bf16_t*)(P.ws + WS_MIX); const bf16_t* KVC = (const bf16_t*)(P.ws + WS_KVC);
    if (tid >= 256) return;
    const int tok = tid >> 2, r = tid & 3, hq = 4 * g + r, t = t0 + tok; const size_t brow = (size_t)b * SEQ;
    const float sl = ex2(-0.5f * (float)(hq + 1)) * LOG2E;
    LAS float* q = (LAS float*)lds + 64 * 256 + tid;
    { const bf16_t* qp = PROJ + (brow + t) * NP + QA_OFF + hq * 64;
#pragma unroll
      for (int d = 0; d < 64; ++d) q[d * 256] = bf2f(qp[d]); }
    float gate[3];
#pragma unroll
    for (int i = 0; i < 3; ++i) { const float gv = bf2f(PROJ[(brow + t) * NP + GATE_OFF + hq * 3 + i]); gate[i] = 1.f / (1.f + expf(-gv)); }
    LAS float* oacc = (LAS float*)lds + tid;
#pragma unroll
    for (int d = 0; d < 64; ++d) oacc[d * 256] = 0.f;
    const bf16_t* kc = KVC + ((size_t)((0 * NB + b) * 4 + g) * 128) * 64; const bf16_t* vc = KVC + ((size_t)((1 * NB + b) * 4 + g) * 128) * 64;
    int nval = 0; if (t >= 31) { nval = ((t - 31) >> 4) + 1; if (nval > NCMP) nval = NCMP; }
    float mc = -INFINITY, lc = 0.f;
    for (int n = 0; n < nval; ++n) { const float s = dot64(q, kc + n * 64) + sl * (float)(16 * n - t0); mc = fmaxf(mc, s); }
    { float o[64];
#pragma unroll
      for (int d = 0; d < 64; ++d) o[d] = 0.f;
      for (int n = 0; n < nval; ++n) { const float s = dot64(q, kc + n * 64) + sl * (float)(16 * n - t0); const float p = exp2f(s - mc); lc += p; axpy64(o, p, vc + n * 64); }
      float sc = lc > 0.f ? gate[0] / lc : 0.f;
#if defined(EXPORT_BR) && EXPORT_BR == 0
      { const float* ob = (const float*)(P.ws + 424 * MiB) + (brow + t) * 1024 + hq * 64; _Pragma("unroll") for (int d = 0; d < 64; ++d) o[d] = ob[d]; sc = gate[0]; }
#endif
#pragma unroll
      for (int d = 0; d < 64; ++d) oacc[d * 256] += o[d] * sc; }
    const int cur = t >> 6; unsigned selmask = 0u;
    { float sc[32];
#pragma unroll
      for (int j = 0; j < 32; ++j) { float acc = 0.f;
#pragma unroll
          for (int i = -1; i < 4; ++i) { const int n = 4 * j + i; const float w = (i == -1 || i == 3) ? 0.5f : 1.f;
              float p = 0.f; if (n >= 0 && n < nval) p = exp2f(dot64(q, kc + n * 64) + sl * (float)(16 * n - t0) - mc) / lc;
              acc += w * p; }
          acc += __shfl_xor(acc, 1); acc += __shfl_xor(acc, 2);
          const bool forced = (j == 0) || (j == cur) || (j == cur - 1);
          sc[j] = (j > cur) ? -1.f : acc + (forced ? 1.0e4f : 0.f); }
#pragma unroll
      for (int j = 0; j < 32; ++j) { int cnt = 0;
#pragma unroll
          for (int i = 0; i < 32; ++i) cnt += ((sc[i] > sc[j]) || (sc[i] == sc[j] && i < j)) ? 1 : 0;
          if (cnt < 8 && j <= cur) selmask |= 1u << j; } }
#if defined(EXPORT_SEL)
    selmask = ((const unsigned*)(P.ws + 490 * MiB))[(b * 4 + g) * SEQ + t];
#endif
    { float o[64]; float m = -INFINITY, l = 0.f;
#pragma unroll
      for (int d = 0; d < 64; ++d) o[d] = 0.f;
      for (int j = 0; j < 32; ++j) { if (!((selmask >> j) & 1u)) continue;
          for (int i = 0; i < 64; ++i) { const int pos = 64 * j + i; if (pos > t) break;
              const bf16_t* kp = PROJ + (brow + pos) * NP + KSLC_OFF + g * 64; const bf16_t* vp = PROJ + (brow + pos) * NP + VSLC_OFF + g * 64;
              const float s = dot64(q, kp) + sl * (float)(pos - t0); const float mn = fmaxf(m, s); const float al = exp2f(m - mn), p = exp2f(s - mn); m = mn; l = l * al + p;
#pragma unroll
              for (int d = 0; d < 64; ++d) o[d] *= al;
              axpy64(o, p, vp); } }
      float sc = l > 0.f ? gate[1] / l : 0.f;
#if defined(EXPORT_BR) && EXPORT_BR == 1
      { const float* ob = (const float*)(P.ws + 424 * MiB) + (brow + t) * 1024 + hq * 64; _Pragma("unroll") for (int d = 0; d < 64; ++d) o[d] = ob[d]; sc = gate[1]; }
#endif
#pragma unroll
      for (int d = 0; d < 64; ++d) oacc[d * 256] += o[d] * sc; }
    { float o[64]; float m = -INFINITY, l = 0.f;
#pragma unroll
      for (int d = 0; d < 64; ++d) o[d] = 0.f;
      const int p0 = t - 511 > 0 ? t - 511 : 0;
      for (int pos = p0; pos <= t; ++pos) {
          const bf16_t* kp = PROJ + (brow + pos) * NP + KWIN_OFF + g * 64; const bf16_t* vp = PROJ + (brow + pos) * NP + VWIN_OFF + g * 64;
          const float s = dot64(q, kp) + sl * (float)(pos - t0); const float mn = fmaxf(m, s); const float al = exp2f(m - mn), p = exp2f(s - mn); m = mn; l = l * al + p;
#pragma unroll
          for (int d = 0; d < 64; ++d) o[d] *= al;
          axpy64(o, p, vp); }
      float sc = l > 0.f ? gate[2] / l : 0.f;
#if defined(EXPORT_BR) && EXPORT_BR == 2
      { const float* ob = (const float*)(P.ws + 424 * MiB) + (brow + t) * 1024 + hq * 64; _Pragma("unroll") for (int d = 0; d < 64; ++d) o[d] = ob[d]; sc = gate[2]; }
#endif
#pragma unroll
      for (int d = 0; d < 64; ++d) oacc[d * 256] += o[d] * sc; }
    float ss = 0.f;
#pragma unroll
    for (int d = 0; d < 64; ++d) ss += oacc[d * 256] * oacc[d * 256];
    const float rstd = 1.f / sqrtf(ss / 64.f + EPSN);
#pragma unroll
    for (int d = 0; d < 64; ++d) { const float z = bf2f(PROJ[(brow + t) * NP + ZA_OFF + hq * 64 + d]);
        MIX[(brow + t) * DM + hq * 64 + d] = f2bf1(oacc[d * 256] * rstd * P.nsa_norm[hq * 64 + d] * (z / (1.f + expf(-z)))); }
}
#endif
#define GAS __attribute__((address_space(1)))
#define XB_TMO      128
#define XB_XCNT(j)  (256  + 64 * (j))
#define XB_XSUB(j)  (1280 + 64 * (j))
#define XB_XGEN(j)  (2304 + 64 * (j))
#define XB_TOP      3328
#define XB_TOPGEN   3392
#define XCD_BAR_WORDS 3456
#define XB_SPIN_CAP (1u << 18)

__device__ __forceinline__ unsigned xb_ld(unsigned* p)              { return __hip_atomic_load(p, __ATOMIC_RELAXED, __HIP_MEMORY_SCOPE_AGENT); }
__device__ __forceinline__ unsigned xb_add(unsigned* p, unsigned v) { return __hip_atomic_fetch_add(p, v, __ATOMIC_RELAXED, __HIP_MEMORY_SCOPE_AGENT); }
__device__ __forceinline__ unsigned xb_xcc_id() { return (unsigned)__builtin_amdgcn_s_getreg((3 << 11) | 20) & 0xFu; }
#define XB_SPIN(cond, bar) do { unsigned _sp = 0; while (cond) { __builtin_amdgcn_s_sleep(1); \
    if ((++_sp & 255u) == 0u) { if (xb_ld(&(bar)[XB_TMO])) break; if (_sp > XB_SPIN_CAP) { atomicAdd(&(bar)[XB_TMO], 1u); break; } } } } while (0)

struct XcdBarrier {
    unsigned* bar; unsigned x;
    volatile LAS unsigned* st;
};

__device__ __forceinline__ XcdBarrier xcd_barrier_post(unsigned* bar, volatile LAS unsigned* st) {
    XcdBarrier b; b.bar = bar; b.x = xb_xcc_id(); b.st = st;
    if (threadIdx.x == 0) (void)xb_add(&bar[XB_XCNT(b.x)], 1u);
    return b;
}
__device__ __forceinline__ void xcd_barrier_complete(unsigned* bar, unsigned x, unsigned& nloc, unsigned& nx) {
    const unsigned G = gridDim.x * gridDim.y * gridDim.z;
    unsigned sum, cnt, mine, sp = 0u;
    for (;;) {
        sum = 0u; cnt = 0u; mine = 0u;
#pragma unroll
        for (unsigned j = 0; j < 16; ++j) { const unsigned c = xb_ld(&bar[XB_XCNT(j)]); sum += c; cnt += (c > 0u) ? 1u : 0u; mine = (j == x) ? c : mine; }
        if (sum == G) break;
        __builtin_amdgcn_s_sleep(1);
        if ((++sp & 255u) == 0u) { if (xb_ld(&bar[XB_TMO])) break; if (sp > XB_SPIN_CAP) { atomicAdd(&bar[XB_TMO], 1u); break; } }
    }
    nloc = mine > 0u ? mine : 1u; nx = cnt > 0u ? cnt : 1u;
}

__device__ __forceinline__ void xcd_barrier(const XcdBarrier& b) {
    asm volatile("s_waitcnt vmcnt(0)" ::: "memory");
    __syncthreads();
    if (threadIdx.x == 0) {
        unsigned* bar = b.bar;
        __builtin_amdgcn_s_waitcnt(0);
        unsigned nloc = b.st[0], nx = b.st[1];
        if (nloc == 0u) { xcd_barrier_complete(bar, b.x, nloc, nx); b.st[0] = nloc; b.st[1] = nx; }
        const unsigned old = xb_add(&bar[XB_XSUB(b.x)], 1u);
        const unsigned gen = old / nloc;
        if (old + 1u == (gen + 1u) * nloc) {
            __builtin_amdgcn_fence(__ATOMIC_RELEASE, "agent");
            asm volatile("s_waitcnt vmcnt(0)" ::: "memory");
            const unsigned og = xb_add(&bar[XB_TOP], 1u);
            const unsigned tg = og / nx;
            if (og + 1u == (tg + 1u) * nx) xb_add(&bar[XB_TOPGEN], 1u);
            else XB_SPIN(xb_ld(&bar[XB_TOPGEN]) == tg, bar);
            __builtin_amdgcn_fence(__ATOMIC_ACQUIRE, "agent");
            xb_add(&bar[XB_XGEN(b.x)], 1u);
            asm volatile("s_waitcnt vmcnt(0)" ::: "memory");
        } else {
            XB_SPIN(xb_ld(&bar[XB_XGEN(b.x)]) == gen, bar);
            __builtin_amdgcn_fence(__ATOMIC_ACQUIRE, "agent");
            asm volatile("s_waitcnt vmcnt(0)" ::: "memory");
        }
    }
    __syncthreads();
}
__device__ __forceinline__ void phase5(const Params& P, int G) {
    const int tid = threadIdx.x, lane = tid & 63, wave = __builtin_amdgcn_readfirstlane(tid >> 6);
    const float* RSP = (const float*)(P.ws + WS_RSP);
    const int gw = blockIdx.x * NWAVES + wave, NGW = G * NWAVES;
    for (int m = gw; m < MROWS; m += NGW) {
        float* row = P.out + (size_t)m * DM;
        f32x4 v[8];
#pragma unroll
        for (int j = 0; j < 8; ++j) v[j] = ((const f32x4*)row)[64 * j + lane];
        float s = lane < 32 ? RSP[(size_t)lane * MROWS + m] : 0.f;
        const float rstd = __builtin_amdgcn_rsqf(wave_sum(s) * (1.f / DM) + EPSN);
#pragma unroll
        for (int j = 0; j < 8; ++j) { const f32x4 gg = ((const f32x4*)P.final_norm)[64 * j + lane]; ((f32x4*)row)[64 * j + lane] = v[j] * rstd * gg; }
    }
}

constexpr int N_HGRN = 64, N_ATTN = 1024;
__global__ void __launch_bounds__(NTHREADS, 2) hymba_fwd(Params P) {
    extern __shared__ __attribute__((aligned(16))) unsigned char lds_raw[];
    LAS unsigned char* lds = (LAS unsigned char*)lds_raw;
    const int G = gridDim.x;
    const int lo = P.ph_lo, hi = P.ph_hi;
#define IN(k) (lo <= (k) && (k) < hi)
#ifndef DUPK
#define DUPK -1
#endif
#define REPS(k) for (int rep = 0; rep < ((DUPK) == (k) ? 2 : 1); ++rep)
#define REPSYNC() do { if (rep) GRIDSYNC(); } while (0)
#ifndef USE_CG
#define USE_CG 0
#endif
#if USE_CG
#define GRIDSYNC() cg::this_grid().sync()
#else
#define GRIDSYNC() xcd_barrier(xbar)
#endif
#define SEAM(k) do { if (IN(k) && IN((k) + 1)) { GRIDSYNC(); } } while (0)
    unsigned char* ws = P.ws;
#if !USE_CG
    if (threadIdx.x < 2) *(volatile LAS unsigned*)(lds + LDS_CTL + 16 + 4 * threadIdx.x) = 0u;
    __syncthreads();
    XcdBarrier xbar = xcd_barrier_post((unsigned*)(ws + WS_CTL) + 1024, (volatile LAS unsigned*)(lds + LDS_CTL + 16));
#endif
    #if !defined(ONLY) || ONLY==0
    if (IN(0)) REPS(0) { REPSYNC(); phase0(P, lds, G); }
#endif
    SEAM(0);
#if !defined(ONLY) || ONLY==1
    if (IN(1)) REPS(1) { REPSYNC();
        pg8::Gemm g{(const pg8::bf16_t*)(ws + WS_HB), (const pg8::bf16_t*)(ws + WS_W1T), MROWS, NP, DM}; pg8::StaticOrder S; S.init(MROWS, NP, G, (int)blockIdx.x);
        pg8::EpiProj E{(pg8::bf16_t*)(ws + WS_PROJ), NP, 4, QSCALE};
        pg8::gemm_phase<pg8::EpiProj, pg8::StaticOrder, true, true>(lds, g, S, E);
    }
#endif
    SEAM(1);
#if !defined(ONLY) || ONLY==2
#if defined(NAIVE_CMP)
    if (IN(2)) { phase2_naive(P, lds, G); }
#else
    if (IN(2)) REPS(2) { REPSYNC(); phase2(P, lds, G); }
#endif
#endif
    SEAM(2);
#if !defined(ONLY) || ONLY==3 || ONLY==30 || ONLY==31
    if (IN(3)) REPS(3) { REPSYNC();
        unsigned* qctr = (unsigned*)(ws + WS_CTL) + 64 * rep;
        for (;;) {
            __syncthreads();
            if (threadIdx.x == 0) *(LAS unsigned*)(lds + LDS_CTL) = atomicAdd(qctr, 1u);
            __syncthreads();
            const int item = (int)__builtin_amdgcn_readfirstlane(*(LAS unsigned*)(lds + LDS_CTL));
#if DUPK == 30
            if (item >= 2 * N_HGRN + N_ATTN) break;
            if (item < 2 * N_HGRN) { hgrn_unit(P, lds, item & (N_HGRN - 1)); continue; } else { attn_unit(P, lds, item - 2 * N_HGRN); continue; }
#elif DUPK == 31
            if (item >= N_HGRN + 2 * N_ATTN) break;
            if (item < N_HGRN) { hgrn_unit(P, lds, item); continue; } else { attn_unit(P, lds, (item - N_HGRN) & (N_ATTN - 1)); continue; }
#endif
            if (item >= N_HGRN + N_ATTN) break;
#if defined(ONLY) && ONLY==30
            hgrn_unit(P, lds, item & 63);
#elif defined(ONLY) && ONLY==31
            attn_unit(P, lds, item & 1023);
#else
#if defined(EXPORT_SEL) || defined(EXPORT_BR)
            if (item < N_HGRN) hgrn_unit(P, lds, item); else attn_unit(P, lds, item - N_HGRN);
#elif defined(NAIVE_ATTN)
            if (item < N_HGRN) hgrn_unit(P, lds, item); else attn_unit_naive(P, lds, item - N_HGRN);
#elif defined(NAIVE_HGRN)
            if (item < N_HGRN) hgrn_unit_naive(P, lds, item); else attn_unit(P, lds, item - N_HGRN);
#else
            if (item < N_HGRN) hgrn_unit(P, lds, item); else attn_unit(P, lds, item - N_HGRN);
#endif
#endif
        }
    }
#endif
    SEAM(3);
#if defined(EXPORT_SEL) || defined(EXPORT_BR)
    if (IN(6)) { for (int u = blockIdx.x; u < N_ATTN; u += G) { __syncthreads(); attn_unit_naive(P, lds, u); } }
#endif
#if !defined(ONLY) || ONLY==4
    if (IN(4)) REPS(4) { REPSYNC();
        pg8::Gemm g{(const pg8::bf16_t*)(ws + WS_MIX), (const pg8::bf16_t*)(ws + WS_WOT), MROWS, DM, DM}; pg8::StaticOrder S; S.init(MROWS, DM, G, (int)blockIdx.x);
        pg8::EpiRes E{P.x, P.out, DM, (float*)(ws + WS_RSP), MROWS};
        pg8::gemm_phase<pg8::EpiRes, pg8::StaticOrder, true, true>(lds, g, S, E);
    }
#endif
    SEAM(4);
#if !defined(ONLY) || ONLY==5
    if (IN(5)) REPS(5) { REPSYNC(); if (rep == 0) phase5(P, G); }
#endif
#undef IN
#undef SEAM
}

extern "C" void kernel_launch(void* const* d_in, const int* in_sizes, int n_in, void* d_out, int out_size, void* d_ws, size_t ws_size, hipStream_t stream) {
    static int grid = 0;
    if (grid == 0) {
        if (n_in != 14 || in_sizes[0] != MROWS * DM || out_size != MROWS * DM || ws_size < WS_END) { fprintf(stderr, "kernel_launch: unexpected shapes (n_in %d, in0 %d, out %d, ws %zu)\n", n_in, n_in > 0 ? in_sizes[0] : -1, out_size, ws_size); grid = -1; return; }
        int dev = 0, cus = 0, per_cu = 0;
        if (hipGetDevice(&dev) != hipSuccess || hipDeviceGetAttribute(&cus, hipDeviceAttributeMultiprocessorCount, dev) != hipSuccess) { grid = -1; return; }
        if (hipFuncSetAttribute((const void*)hymba_fwd, hipFuncAttributeMaxDynamicSharedMemorySize, LDS_BYTES) != hipSuccess) { fprintf(stderr, "kernel_launch: hipFuncSetAttribute failed\n"); grid = -1; return; }
        if (hipOccupancyMaxActiveBlocksPerMultiprocessor(&per_cu, (const void*)hymba_fwd, NTHREADS, LDS_BYTES) != hipSuccess || per_cu < 1) { fprintf(stderr, "kernel_launch: occupancy query says %d blocks per CU\n", per_cu); per_cu = 1; }
        (void)hipGetLastError();
        grid = cus;
    }
    if (grid < 0) return;
    (void)hipMemsetAsync((char*)d_ws + WS_CTL, 0, 32768, stream);
    Params p{};
    p.x = (const float*)d_in[0]; p.norm_in = (const float*)d_in[1]; p.w_in = (const float*)d_in[2]; p.pe_k = (const float*)d_in[3]; p.w1_k = (const float*)d_in[4]; p.w2_k = (const float*)d_in[5];
    p.pe_v = (const float*)d_in[6]; p.w1_v = (const float*)d_in[7]; p.w2_v = (const float*)d_in[8]; p.lower_bounds = (const float*)d_in[9]; p.nsa_norm = (const float*)d_in[10]; p.hgrn_norm = (const float*)d_in[11];
    p.w_out = (const float*)d_in[12]; p.final_norm = (const float*)d_in[13]; p.out = (float*)d_out; p.ws = (unsigned char*)d_ws;
#if MK_LAUNCHES == 1
    p.ph_lo = 0; p.ph_hi = 6;
    void* args[] = {&p};
    hipError_t e = hipLaunchCooperativeKernel((const void*)hymba_fwd, dim3(grid), dim3(NTHREADS), args, LDS_BYTES, stream);
    if (e != hipSuccess) fprintf(stderr, "kernel_launch: cooperative launch failed: %s (grid %d)\n", hipGetErrorString(e), grid);
#else
    for (int ph = 0; ph < 6; ++ph) { p.ph_lo = ph; p.ph_hi = ph + 1; hipLaunchKernelGGL(hymba_fwd, dim3(grid), dim3(NTHREADS), LDS_BYTES, stream, p);
#if defined(EXPORT_SEL) || defined(EXPORT_BR)
        if (ph == 3) { p.ph_lo = 6; p.ph_hi = 7; hipLaunchKernelGGL(hymba_fwd, dim3(grid), dim3(NTHREADS), LDS_BYTES, stream, p); }
#endif
    }
#endif
}
```
